# Optimizing an MI355X kernel written in HIP

```python
import jax, jax.numpy as jnp
from jax import lax
import numpy as np

D_MODEL = 1024
BATCH = 8
SEQ = 4096
DEPTH = 2

D_MIX = D_MODEL
D_SGU = D_MIX // 2
SGU_GROUPS = 4
SGU_GROUP_DIM = D_SGU // SGU_GROUPS
CHUNK = 128
D_ATTN = D_MIX - D_SGU
N_HEADS = 4
HEAD_DIM = D_ATTN // N_HEADS // 2
V_HEAD_DIM = 2 * HEAD_DIM
ROT_DIM = HEAD_DIM // 4
ROPE_THETA = 500000.0
Q_BLOCK = 128
D_FF = 2816
CONV_WIDTH = 3
EPS = 1e-6
D_IN = 2 * D_SGU + 3 * D_ATTN

kernel_name = "hybrid_sgu_diffattn_convffn"


def rmsnorm(x, g):
    xf = x.astype(jnp.float32)
    y = xf * lax.rsqrt(jnp.mean(xf * xf, axis=-1, keepdims=True) + EPS)
    return (y * g.astype(jnp.float32)).astype(x.dtype)


def apply_partial_rope(t, cos, sin):
    half = ROT_DIM // 2
    t1 = t[..., :half]
    t2 = t[..., half:ROT_DIM]
    rot = jnp.concatenate([t1 * cos - t2 * sin, t2 * cos + t1 * sin], axis=-1)
    return jnp.concatenate([rot.astype(t.dtype), t[..., ROT_DIM:]], axis=-1)


def sgu_mixer(u, v, v_gain, w_s, b_s):
    B, S, _ = u.shape
    n_chunks = S // CHUNK
    vg = rmsnorm(v.reshape(B, S, SGU_GROUPS, SGU_GROUP_DIM), v_gain.reshape(SGU_GROUPS, SGU_GROUP_DIM))
    vg = vg.reshape(B, n_chunks, CHUNK, SGU_GROUPS, SGU_GROUP_DIM)
    causal = jnp.tril(jnp.ones((CHUNK, CHUNK), dtype=bool))
    w = jnp.where(causal[None], w_s, jnp.zeros_like(w_s))
    mixed = jnp.einsum('gpq,bcqgd->bcpgd', w, vg) + b_s.T[None, None, :, :, None]
    return u * mixed.reshape(B, S, D_SGU)


def diff_attention(q, k, v, positions, lq1, lk1, lq2, lk2, subln_g, layer_idx):
    B, S, _ = q.shape
    q = q.reshape(B, S, N_HEADS, 2, HEAD_DIM)
    k = k.reshape(B, S, N_HEADS, 2, HEAD_DIM)
    v = v.reshape(B, S, N_HEADS, V_HEAD_DIM)
    inv_freq = ROPE_THETA ** (-jnp.arange(0, ROT_DIM, 2, dtype=jnp.float32) / ROT_DIM)
    ang = positions.astype(jnp.float32)[..., None] * inv_freq
    cos = jnp.cos(ang)[:, :, None, None, :]
    sin = jnp.sin(ang)[:, :, None, None, :]
    q = apply_partial_rope(q, cos, sin)
    k = apply_partial_rope(k, cos, sin)

    lambda_init = 0.8 - 0.6 * float(np.exp(-0.3 * layer_idx))
    lam = (jnp.exp(jnp.sum(lq1.astype(jnp.float32) * lk1.astype(jnp.float32)))
           - jnp.exp(jnp.sum(lq2.astype(jnp.float32) * lk2.astype(jnp.float32)))
           + lambda_init)
    scale = HEAD_DIM ** -0.5

    outs = []
    for start in range(0, S, Q_BLOCK):
        end = start + Q_BLOCK
        qb = q[:, start:end]
        kb = k[:, :end]
        scores = jnp.einsum('bqhmd,bkhmd->bhmqk', qb, kb).astype(jnp.float32) * scale
        q_idx = start + jnp.arange(Q_BLOCK)
        k_idx = jnp.arange(end)
        mask = k_idx[None, :] <= q_idx[:, None]
        scores = jnp.where(mask, scores, -jnp.inf)
        p = jax.nn.softmax(scores, axis=-1)
        attn = p[:, :, 0] - lam * p[:, :, 1]
        outs.append(jnp.einsum('bhqk,bkhd->bqhd', attn.astype(v.dtype), v[:, :end]))
    o = jnp.concatenate(outs, axis=1)
    o = rmsnorm(o, subln_g) * (1.0 - lambda_init)
    return o.reshape(B, S, D_ATTN)


def conv_ffn(h, w_up, conv_w, conv_b, w_down):
    S = h.shape[1]
    up = h @ w_up
    up_p = jnp.pad(up, ((0, 0), (CONV_WIDTH - 1, 0), (0, 0)))
    conv = conv_b
    for j in range(CONV_WIDTH):
        conv = conv + up_p[:, j:j + S] * conv_w[j]
    gate, val = jnp.split(conv, 2, axis=-1)
    return (jax.nn.silu(gate) * val) @ w_down


def setup_inputs(seed: int = 0) -> dict:
    key = jax.random.key(seed)
    ks = jax.random.split(key, 20)
    f32 = jnp.float32
    x = jax.random.normal(ks[0], (BATCH, SEQ, D_MODEL), f32)
    positions = jnp.tile(jnp.arange(SEQ, dtype=jnp.int32)[None, :], (BATCH, 1))
    attn_norm = 1.0 + 0.02 * jax.random.normal(ks[1], (DEPTH, D_MODEL), f32)
    w_in = jax.random.normal(ks[2], (DEPTH, D_MODEL, D_IN), f32) * D_MODEL ** -0.5
    sgu_v_norm = 1.0 + 0.02 * jax.random.normal(ks[3], (DEPTH, D_SGU), f32)
    sgu_w_spatial = jax.random.normal(ks[4], (DEPTH, SGU_GROUPS, CHUNK, CHUNK), f32) * CHUNK ** -0.5
    sgu_b_spatial = 1.0 + 0.02 * jax.random.normal(ks[5], (DEPTH, SGU_GROUPS, CHUNK), f32)
    lambda_q1 = 0.1 * jax.random.normal(ks[6], (DEPTH, HEAD_DIM), f32)
    lambda_k1 = 0.1 * jax.random.normal(ks[7], (DEPTH, HEAD_DIM), f32)
    lambda_q2 = 0.1 * jax.random.normal(ks[8], (DEPTH, HEAD_DIM), f32)
    lambda_k2 = 0.1 * jax.random.normal(ks[9], (DEPTH, HEAD_DIM), f32)
    subln_gain = 1.0 + 0.02 * jax.random.normal(ks[10], (DEPTH, V_HEAD_DIM), f32)
    w_out = jax.random.normal(ks[11], (DEPTH, D_MIX, D_MODEL), f32) * D_MIX ** -0.5
    ffn_norm = 1.0 + 0.02 * jax.random.normal(ks[12], (DEPTH, D_MODEL), f32)
    w_up = jax.random.normal(ks[13], (DEPTH, D_MODEL, 2 * D_FF), f32) * D_MODEL ** -0.5
    conv_w = jax.random.normal(ks[14], (DEPTH, CONV_WIDTH, 2 * D_FF), f32) * CONV_WIDTH ** -0.5
    conv_b = 0.02 * jax.random.normal(ks[15], (DEPTH, 2 * D_FF), f32)
    w_down = jax.random.normal(ks[16], (DEPTH, D_FF, D_MODEL), f32) * D_FF ** -0.5
    final_norm = 1.0 + 0.02 * jax.random.normal(ks[17], (D_MODEL,), f32)
    return {"x": x, "positions": positions, "attn_norm": attn_norm, "w_in": w_in,
            "sgu_v_norm": sgu_v_norm, "sgu_w_spatial": sgu_w_spatial, "sgu_b_spatial": sgu_b_spatial,
            "lambda_q1": lambda_q1, "lambda_k1": lambda_k1, "lambda_q2": lambda_q2, "lambda_k2": lambda_k2,
            "subln_gain": subln_gain, "w_out": w_out, "ffn_norm": ffn_norm, "w_up": w_up,
            "conv_w": conv_w, "conv_b": conv_b, "w_down": w_down, "final_norm": final_norm}


def reference(x, positions, attn_norm, w_in, sgu_v_norm, sgu_w_spatial, sgu_b_spatial,
              lambda_q1, lambda_k1, lambda_q2, lambda_k2, subln_gain, w_out, ffn_norm,
              w_up, conv_w, conv_b, w_down, final_norm):
    h = x
    for l in range(DEPTH):
        n = rmsnorm(h, attn_norm[l])
        proj = n @ w_in[l]
        u, v_sgu, q, k, v_att = jnp.split(
            proj, [D_SGU, 2 * D_SGU, 2 * D_SGU + D_ATTN, 2 * D_SGU + 2 * D_ATTN], axis=-1)
        u = jax.nn.gelu(u)
        v_sgu = jax.nn.gelu(v_sgu)
        y_sgu = sgu_mixer(u, v_sgu, sgu_v_norm[l], sgu_w_spatial[l], sgu_b_spatial[l])
        y_att = diff_attention(q, k, v_att, positions, lambda_q1[l], lambda_k1[l],
                               lambda_q2[l], lambda_k2[l], subln_gain[l], l)
        mixed = jnp.concatenate([y_sgu, y_att], axis=-1)
        h = h + mixed @ w_out[l]
        h = h + conv_ffn(rmsnorm(h, ffn_norm[l]), w_up[l], conv_w[l], conv_b[l], w_down[l])
    return rmsnorm(h, final_norm)
```

```cpp
#include <hip/hip_runtime.h>
#include <hip/hip_cooperative_groups.h>
#include <cstdio>
#include <cstdint>
namespace pg8 {
#define PG8_LAS __attribute__((address_space(3)))
typedef unsigned short bf16_t;
typedef short bf16x8 __attribute__((ext_vector_type(8)));
typedef float f32x4 __attribute__((ext_vector_type(4)));
typedef unsigned u32x4 __attribute__((ext_vector_type(4)));
constexpr int BM = 256, BK = 64, HALF = 128, HTB = HALF * BK * 2  , STAGE_BYTES = 8 * HTB, NXCD = 8, WGM = 8;

__host__ __device__ __forceinline__ int lds_byte(int r, int c) { const int st = (r >> 4) * 2 + (c >> 5), rr = r & 15, cc = c & 31, ob = rr * 64 + cc * 2; return st * 1024 + (ob ^ (((ob >> 9) & 1) << 5)); }
__host__ __device__ __forceinline__ void stage_rc(int b, int& R, int& C) { const int st = b / 1024, sb = b % 1024, swz = sb ^ (((sb >> 9) & 1) << 5); R = (st >> 1) * 16 + swz / 64; C = (st & 1) * 32 + (swz % 64) / 2; }
__host__ __device__ __forceinline__ int perm32(int rho) { const int n = rho >> 4, i = rho & 15; return 8 * (i >> 2) + 4 * n + (i & 3); }

struct Unit { int pm, pn; };
struct Gemm { const bf16_t* A; const bf16_t* Bt; int M, N, K; };

struct StaticOrder {
    int nM, nN, nwg, G, c;
    __host__ __device__ void init(int M, int N, int G_, int c_) { nM = M / BM; nN = N / BM; nwg = nM * nN; G = G_; c = c_; }
    __host__ __device__ bool next(int i, Unit& u) const {
        const long L = (long)i * G + c; if (L >= nwg) return false;
        int wgid = (int)L; { const int q = nwg / NXCD, r = nwg % NXCD, xcd = wgid % NXCD, off = wgid / NXCD; wgid = (xcd < r ? xcd * (q + 1) : r * (q + 1) + (xcd - r) * q) + off; }
        const int nig = WGM * nN, gid = wgid / nig, fm = gid * WGM, gsz = (nM - fm) < WGM ? (nM - fm) : WGM;
        u.pm = fm + ((wgid % nig) % gsz); u.pn = (wgid % nig) / gsz; return true;
    }
    __device__ __forceinline__ void a_ready(const Unit&) const {}
    __device__ __forceinline__ void done(const Unit&) const {}
};

typedef float f32x2 __attribute__((ext_vector_type(2)));
typedef __bf16 bf16x2_t __attribute__((ext_vector_type(2)));
__device__ __forceinline__ unsigned cvt_pk_bf16(float lo, float hi) { f32x2 v = {lo, hi}; bf16x2_t b = __builtin_convertvector(v, bf16x2_t); return __builtin_bit_cast(unsigned, b); }
__device__ __forceinline__ u32x4 pack8(f32x4 v0, f32x4 v1) { u32x4 w; w.x = cvt_pk_bf16(v0[0], v0[1]); w.y = cvt_pk_bf16(v0[2], v0[3]); w.z = cvt_pk_bf16(v1[0], v1[1]); w.w = cvt_pk_bf16(v1[2], v1[3]); return w; }
__device__ __forceinline__ float gelu_tanh(float x) {
    const float u = x * (1.0f + 0.044715f * x * x);
    const float e = __builtin_amdgcn_exp2f(u * (-2.0f * 0.7978845608028654f * 1.4426950408889634f));
    return x * __builtin_amdgcn_rcpf(1.0f + e);
}
__device__ __forceinline__ float silu_f(float x) { return x * __builtin_amdgcn_rcpf(1.0f + __builtin_amdgcn_exp2f(x * -1.4426950408889634f)); }
__device__ __forceinline__ float row_rs(const float* part, int row) {
    const f32x4* p = (const f32x4*)(part + (size_t)row * 16);
    const f32x4 a = p[0], b = p[1], c = p[2], d = p[3];
    const float s = (((a[0] + a[1]) + (a[2] + a[3])) + ((b[0] + b[1]) + (b[2] + b[3]))) + (((c[0] + c[1]) + (c[2] + c[3])) + ((d[0] + d[1]) + (d[2] + d[3])));
    return __builtin_amdgcn_rsqf(s * (1.0f / 1024.0f) + 1e-6f);
}

struct EpiInProj {
    static constexpr bool PERM = true, AFTER_DRAIN = false;
    const float* part; const float* cs; const float* sn; bf16_t* R; float qscale; size_t seg_stride;
    __device__ __forceinline__ void operator()(const f32x4 (&acc)[2][2][4][2], const Unit& u, int wr, int wc, int fr, int fq) const {
        const int t = u.pn >> 1;
        bf16_t* O = R + (size_t)t * seg_stride;
        const int colt = (u.pn & 1) * 256 + wc * 32 + 8 * fq;
        const bool isrope = (t == 2 || t == 3);
        const bool roper = isrope && ((wc & 1) == 0) && (fq < 2);
        const float qs = (t == 2) ? qscale : 1.0f;
#pragma unroll
        for (int ai = 0; ai < 2; ++ai)
#pragma unroll
            for (int m = 0; m < 4; ++m) {
                const int row = u.pm * BM + ai * HALF + wr * 64 + m * 16 + fr;
                const float rs = row_rs(part, row);
                f32x4 cv = {1.f, 1.f, 1.f, 1.f}, sv = {0.f, 0.f, 0.f, 0.f};
                if (isrope) { cv = *(const f32x4*)(cs + (size_t)row * 8 + 4 * (fq & 1)); sv = *(const f32x4*)(sn + (size_t)row * 8 + 4 * (fq & 1)); }
                bf16_t* rowp = O + (size_t)row * 512 + colt;
#pragma unroll
                for (int bj = 0; bj < 2; ++bj) {
                    f32x4 v0 = acc[ai][bj][m][0] * rs, v1 = acc[ai][bj][m][1] * rs;
                    if (t < 2) {
#pragma unroll
                        for (int j = 0; j < 4; ++j) { v0[j] = gelu_tanh(v0[j]); v1[j] = gelu_tanh(v1[j]); }
                    } else if (isrope) {
                        if (roper) {
                            const float a0 = v0[0], b0 = v0[1], a1 = v0[2], b1 = v0[3], a2 = v1[0], b2 = v1[1], a3 = v1[2], b3 = v1[3];
                            v0[0] = a0 * cv[0] - b0 * sv[0]; v0[1] = b0 * cv[0] + a0 * sv[0];
                            v0[2] = a1 * cv[1] - b1 * sv[1]; v0[3] = b1 * cv[1] + a1 * sv[1];
                            v1[0] = a2 * cv[2] - b2 * sv[2]; v1[1] = b2 * cv[2] + a2 * sv[2];
                            v1[2] = a3 * cv[3] - b3 * sv[3]; v1[3] = b3 * cv[3] + a3 * sv[3];
                        }
                        v0 = v0 * qs; v1 = v1 * qs;
                    }
                    *(u32x4*)(rowp + bj * HALF) = pack8(v0, v1);
                }
            }
    }
};

struct EpiResid {
    static constexpr bool PERM = true, AFTER_DRAIN = false;
    const float* base; float* out; bf16_t* hb; const float* g; float* part;
    __device__ __forceinline__ void operator()(const f32x4 (&acc)[2][2][4][2], const Unit& u, int wr, int wc, int fr, int fq) const {
        const int col0 = u.pn * BM + wc * 32 + 8 * fq;
        f32x4 gv[2][2];
#pragma unroll
        for (int bj = 0; bj < 2; ++bj)
#pragma unroll
            for (int n = 0; n < 2; ++n) gv[bj][n] = *(const f32x4*)(g + col0 + bj * HALF + 4 * n);
#pragma unroll
        for (int ai = 0; ai < 2; ++ai)
#pragma unroll
            for (int m = 0; m < 4; ++m) {
                const int row = u.pm * BM + ai * HALF + wr * 64 + m * 16 + fr;
                const size_t off = (size_t)row * 1024 + col0;
                float ss = 0.f;
#pragma unroll
                for (int bj = 0; bj < 2; ++bj) {
                    const f32x4 h0 = *(const f32x4*)(base + off + bj * HALF) + acc[ai][bj][m][0];
                    const f32x4 h1 = *(const f32x4*)(base + off + bj * HALF + 4) + acc[ai][bj][m][1];
                    *(f32x4*)(out + off + bj * HALF) = h0; *(f32x4*)(out + off + bj * HALF + 4) = h1;
                    ss += ((h0[0] * h0[0] + h0[1] * h0[1]) + (h0[2] * h0[2] + h0[3] * h0[3])) + ((h1[0] * h1[0] + h1[1] * h1[1]) + (h1[2] * h1[2] + h1[3] * h1[3]));
                    if (hb) *(u32x4*)(hb + off + bj * HALF) = pack8(h0 * gv[bj][0], h1 * gv[bj][1]);
                }
                ss += __int_as_float(__builtin_amdgcn_ds_bpermute(4 * ((fq * 16 + fr) ^ 16), __float_as_int(ss))); ss += __int_as_float(__builtin_amdgcn_ds_bpermute(4 * ((fq * 16 + fr) ^ 32), __float_as_int(ss)));
                if (fq == 0) part[(size_t)row * 16 + u.pn * 4 + wc] = ss;
            }
    }
};

struct EpiUp {
    static constexpr bool PERM = true, AFTER_DRAIN = false;
    const float* part; const float* cw; const float* cb; bf16_t* act; float* top; float* bot;
    __device__ __forceinline__ void operator()(f32x4 (&acc)[2][2][4][2], const Unit& u, int wr, int wc, int fr_in, int fq_in) const {
        int fr = fr_in, fq = fq_in; asm volatile("" : "+v"(fr), "+v"(fq));
        const int cbase = u.pn * 128 + wc * 32 + 8 * fq;
#ifndef UP_NO1
        {
            const f32x4* pp = (const f32x4*)(part + (size_t)(u.pm * BM + wr * 64 + fr) * 16);
            f32x4 pa = pp[0], pb = pp[1], pc = pp[2], pd = pp[3];
#pragma unroll
            for (int r = 0; r < 8; ++r) {
                const int ai = r >> 2, m = r & 3;
                f32x4 na = pa, nb = pb, nc = pc, nd = pd;
                if (r < 7) { const int r1 = r + 1; const f32x4* pn = pp + (size_t)((r1 >> 2) * HALF + (r1 & 3) * 16) * 4; na = pn[0]; nb = pn[1]; nc = pn[2]; nd = pn[3]; }
                const float s = (((pa[0] + pa[1]) + (pa[2] + pa[3])) + ((pb[0] + pb[1]) + (pb[2] + pb[3]))) + (((pc[0] + pc[1]) + (pc[2] + pc[3])) + ((pd[0] + pd[1]) + (pd[2] + pd[3])));
                float rs = __builtin_amdgcn_rsqf(s * (1.0f / 1024.0f) + 1e-6f);
                asm volatile("" : "+v"(rs) :: "memory");
#pragma unroll
                for (int bj = 0; bj < 2; ++bj)
#pragma unroll
                    for (int n = 0; n < 2; ++n) acc[ai][bj][m][n] = acc[ai][bj][m][n] * rs;
                pa = na; pb = nb; pc = nc; pd = nd;
            }
        }
        asm volatile("" ::: "memory");
#endif
#ifndef UP_NO2
#pragma unroll
        for (int ai = 0; ai < 2; ++ai) { const int blk = (u.pm * BM + ai * HALF + wr * 64) >> 6;
#pragma unroll
            for (int n = 0; n < 2; ++n) { const int ch = cbase + 4 * n;
                if (fr < 2) { float* tp = top + (size_t)(blk * 2 + fr) * 5632 + ch; *(f32x4*)tp = acc[ai][0][0][n]; *(f32x4*)(tp + 2816) = acc[ai][1][0][n]; }
                if (fr >= 14) { float* bp = bot + (size_t)(blk * 2 + (fr - 14)) * 5632 + ch; *(f32x4*)bp = acc[ai][0][3][n]; *(f32x4*)(bp + 2816) = acc[ai][1][3][n]; } } }
#endif
#ifndef UP_NO3
        asm volatile("" ::: "memory");
        {
            float c0 = cw[cbase], c1 = cw[5632 + cbase], c2 = cw[2 * 5632 + cbase], c3 = cb[cbase];
            float c4 = cw[2816 + cbase], c5 = cw[5632 + 2816 + cbase], c6 = cw[2 * 5632 + 2816 + cbase], c7 = cb[2816 + cbase];
#pragma unroll
            for (int k = 0; k < 8; ++k) {
                const int n = k >> 2, j = k & 3;
                float d0 = c0, d1 = c1, d2 = c2, d3 = c3, d4 = c4, d5 = c5, d6 = c6, d7 = c7;
                if (k < 7) { const int ch = cbase + k + 1; d0 = cw[ch]; d1 = cw[5632 + ch]; d2 = cw[2 * 5632 + ch]; d3 = cb[ch]; d4 = cw[2816 + ch]; d5 = cw[5632 + 2816 + ch]; d6 = cw[2 * 5632 + 2816 + ch]; d7 = cb[2816 + ch]; }
                asm volatile("" ::: "memory");
                const f32x2 W0 = {c0, c4}, W1 = {c1, c5}, W2 = {c2, c6}, Bc = {c3, c7};
#pragma unroll
                for (int ai = 0; ai < 2; ++ai)
#pragma unroll
                    for (int m = 3; m >= 0; --m) {
                        const f32x2 x = {acc[ai][0][m][n][j], acc[ai][1][m][n][j]};
                        f32x2 p = {0.f, 0.f};
                        if (m > 0) { p.x = acc[ai][0][m > 0 ? m - 1 : 0][n][j]; p.y = acc[ai][1][m > 0 ? m - 1 : 0][n][j]; }
                        const f32x2 s1 = (fr == 15) ? p : x, s2 = (fr >= 14) ? p : x;
                        f32x2 r1, r2;
                        r1.x = __int_as_float(__builtin_amdgcn_update_dpp(0, __float_as_int(s1.x), 0x121, 0xf, 0xf, false)); r1.y = __int_as_float(__builtin_amdgcn_update_dpp(0, __float_as_int(s1.y), 0x121, 0xf, 0xf, false));
                        r2.x = __int_as_float(__builtin_amdgcn_update_dpp(0, __float_as_int(s2.x), 0x122, 0xf, 0xf, false)); r2.y = __int_as_float(__builtin_amdgcn_update_dpp(0, __float_as_int(s2.y), 0x122, 0xf, 0xf, false));
                        const f32x2 c = Bc + W2 * x + W1 * r1 + W0 * r2;
                        float o = silu_f(c.x) * c.y;
                        asm volatile("" : "+v"(o));
                        acc[ai][0][m][n][j] = o;
                    }
                c0 = d0; c1 = d1; c2 = d2; c3 = d3; c4 = d4; c5 = d5; c6 = d6; c7 = d7;
            }
        }
        asm volatile("" ::: "memory");
#endif
#pragma unroll
        for (int ai = 0; ai < 2; ++ai)
#pragma unroll
            for (int m = 0; m < 4; ++m) { const int row = u.pm * BM + ai * HALF + wr * 64 + m * 16 + fr;
                if (!(m == 0 && fr < 2)) *(u32x4*)(act + (size_t)row * 2816 + cbase) = pack8(acc[ai][0][m][0], acc[ai][0][m][1]); }
    }
};

template <class Epi, class Sched, bool ALIGN_EPI = false, bool SP2 = false>
__device__ __forceinline__ void gemm_phase(PG8_LAS unsigned char* lds, const Gemm g, const Sched& S, const Epi& E, const int tid) {
    const int wid = __builtin_amdgcn_readfirstlane(tid >> 6), lane = tid & 63, wr = wid >> 2, wc = wid & 3, fr = lane & 15, fq = lane >> 4;
    const int K = g.K, nt = K / BK;
    unsigned voffA[2], voffB[2];
#pragma unroll
    for (int i = 0; i < 2; ++i) { int R, C; stage_rc(tid * 16 + i * 8192, R, C); const int Rb = Epi::PERM ? ((R & ~31) + perm32(R & 31)) : R;
        voffA[i] = (unsigned)(R * K + C) * 2u; voffB[i] = (unsigned)(Rb * K + C) * 2u; }
    const size_t kstep = (size_t)(BK * 2);
    const size_t hstep = (size_t)HALF * K * 2;
    const size_t tstep = 2 * hstep;
    const unsigned ldsw = (unsigned)wid * 1024u;
    const int aoff = lds_byte(wr * 64 + fr, fq * 8), boff = lds_byte(wc * 32 + fr, fq * 8);
#define PG8_SA(b, h) (((b) * 2 + (h)) * HTB)
#define PG8_SB(b, h) ((4 + (b) * 2 + (h)) * HTB)
#define PG8_STAGE(bufoff, gbase, voff) do { _Pragma("unroll") for (int _i = 0; _i < 2; ++_i) \
        __builtin_amdgcn_global_load_lds((const unsigned*)((const char*)(gbase) + (voff)[_i]), (PG8_LAS unsigned*)(lds + (bufoff) + ldsw + _i * 8192), 16, 0, 0); } while (0)
#define PG8_LDA(dst, b, h) do { _Pragma("unroll") for (int m = 0; m < 4; ++m) _Pragma("unroll") for (int k = 0; k < 2; ++k) dst[m][k] = *(const PG8_LAS bf16x8*)(lds + PG8_SA(b, h) + aoff + m * 2048 + k * 1024); } while (0)
#define PG8_LDB(dst, b, h) do { _Pragma("unroll") for (int n = 0; n < 2; ++n) _Pragma("unroll") for (int k = 0; k < 2; ++k) dst[n][k] = *(const PG8_LAS bf16x8*)(lds + PG8_SB(b, h) + boff + n * 2048 + k * 1024); } while (0)
#define PG8_MMA(ai, bj, At, Bt) do { __builtin_amdgcn_s_setprio(1); _Pragma("unroll") for (int m = 0; m < 4; ++m) _Pragma("unroll") for (int n = 0; n < 2; ++n) _Pragma("unroll") for (int k = 0; k < 2; ++k) \
        acc[ai][bj][m][n] = __builtin_amdgcn_mfma_f32_16x16x32_bf16(Bt[n][k], At[m][k], acc[ai][bj][m][n], 0, 0, 0); __builtin_amdgcn_s_setprio(0); } while (0)
#define PG8_WAIT_V(n) asm volatile("s_waitcnt vmcnt(" #n ")" ::: "memory")
#define PG8_WAIT_L(n) asm volatile("s_waitcnt lgkmcnt(" #n ")" ::: "memory")
#define PG8_BAR __builtin_amdgcn_s_barrier()
#define PG8_SCHED __builtin_amdgcn_sched_barrier(0)
    Unit cur, nxt; int ui = 0;
    if (!S.next(0, cur)) return;
    f32x4 acc[2][2][4][2];
#pragma unroll
    for (int a = 0; a < 2; ++a)
#pragma unroll
        for (int b = 0; b < 2; ++b)
#pragma unroll
            for (int m = 0; m < 4; ++m)
#pragma unroll
                for (int n = 0; n < 2; ++n) acc[a][b][m][n] = (f32x4){0.f, 0.f, 0.f, 0.f};
    bf16x8 At[4][2], B0[2][2], B1[2][2];
    const char* cA = (const char*)g.A + (size_t)cur.pm * tstep; const char* cB = (const char*)g.Bt + (size_t)cur.pn * tstep;
    S.a_ready(cur);
    if constexpr (SP2) {
        PG8_STAGE(PG8_SB(0, 0), cB, voffB); PG8_STAGE(PG8_SB(0, 1), cB + hstep, voffB); PG8_STAGE(PG8_SA(0, 0), cA, voffA); PG8_STAGE(PG8_SA(0, 1), cA + hstep, voffA);
        if (wr == 1) PG8_BAR;
        PG8_WAIT_V(2); PG8_BAR;
        PG8_STAGE(PG8_SB(1, 0), cB + kstep, voffB); PG8_STAGE(PG8_SA(1, 0), cA + kstep, voffA); PG8_STAGE(PG8_SB(1, 1), cB + hstep + kstep, voffB);
        PG8_WAIT_V(6); PG8_BAR;
    } else {
        PG8_STAGE(PG8_SB(0, 0), cB, voffB); PG8_STAGE(PG8_SA(0, 0), cA, voffA); PG8_STAGE(PG8_SB(0, 1), cB + hstep, voffB); PG8_STAGE(PG8_SA(0, 1), cA + hstep, voffA);
        if (wr == 1) PG8_BAR;
        PG8_WAIT_V(4); PG8_BAR;
        PG8_STAGE(PG8_SB(1, 0), cB + kstep, voffB); PG8_STAGE(PG8_SA(1, 0), cA + kstep, voffA); PG8_STAGE(PG8_SB(1, 1), cB + hstep + kstep, voffB);
        PG8_WAIT_V(6); PG8_BAR;
    }
    for (;;) {
        const bool has_next = S.next(ui + 1, nxt);
        const char* nA = has_next ? (const char*)g.A + (size_t)nxt.pm * tstep : cA; const char* nB = has_next ? (const char*)g.Bt + (size_t)nxt.pn * tstep : cB;
        for (int t = 0; t < nt; t += 2) {
            const bool last = (t == nt - 2);
            const char* a1 = cA + (size_t)(t + 1) * kstep;
            const char* a2 = last ? nA : cA + (size_t)(t + 2) * kstep; const char* b2 = last ? nB : cB + (size_t)(t + 2) * kstep;
            const char* a3 = a2 + kstep; const char* b3 = b2 + kstep;
            if (last && has_next) S.a_ready(nxt);
            if constexpr (SP2) {
            PG8_LDB(B0, 0, 0); PG8_LDB(B1, 0, 1); PG8_SCHED; PG8_LDA(At, 0, 0); PG8_STAGE(PG8_SA(1, 1), a1 + hstep, voffA);
            PG8_WAIT_V(8); PG8_WAIT_L(0); PG8_BAR; PG8_MMA(0, 0, At, B0); PG8_MMA(0, 1, At, B1); PG8_BAR; PG8_SCHED;
            PG8_LDA(At, 0, 1); PG8_STAGE(PG8_SB(0, 0), b2, voffB); PG8_STAGE(PG8_SB(0, 1), b2 + hstep, voffB); PG8_STAGE(PG8_SA(0, 0), a2, voffA);
            PG8_WAIT_V(8); PG8_WAIT_L(0); PG8_BAR; PG8_MMA(1, 0, At, B0); PG8_MMA(1, 1, At, B1); PG8_BAR; PG8_SCHED;
            PG8_LDB(B0, 1, 0); PG8_LDB(B1, 1, 1); PG8_SCHED; PG8_LDA(At, 1, 0); PG8_STAGE(PG8_SA(0, 1), a2 + hstep, voffA);
            PG8_WAIT_V(8); PG8_WAIT_L(0); PG8_BAR; PG8_MMA(0, 0, At, B0); PG8_MMA(0, 1, At, B1); PG8_BAR; PG8_SCHED;
            PG8_LDA(At, 1, 1); PG8_STAGE(PG8_SB(1, 0), b3, voffB); PG8_STAGE(PG8_SB(1, 1), b3 + hstep, voffB); PG8_STAGE(PG8_SA(1, 0), a3, voffA);
            PG8_WAIT_V(8); PG8_WAIT_L(0); PG8_BAR; PG8_MMA(1, 0, At, B0); PG8_MMA(1, 1, At, B1); PG8_BAR; PG8_SCHED;
            } else {
            PG8_LDB(B0, 0, 0); PG8_SCHED; PG8_LDA(At, 0, 0); PG8_STAGE(PG8_SA(1, 1), a1 + hstep, voffA);
            PG8_WAIT_L(8); PG8_BAR; PG8_WAIT_L(0); PG8_MMA(0, 0, At, B0); PG8_BAR; PG8_SCHED;
            PG8_LDB(B1, 0, 1); PG8_STAGE(PG8_SB(0, 0), b2, voffB);
            PG8_BAR; PG8_WAIT_L(0); PG8_MMA(0, 1, At, B1); PG8_BAR;
            PG8_LDA(At, 0, 1); PG8_STAGE(PG8_SA(0, 0), a2, voffA);
            PG8_BAR; PG8_WAIT_L(0); PG8_MMA(1, 0, At, B0); PG8_BAR; PG8_SCHED;
            PG8_STAGE(PG8_SB(0, 1), b2 + hstep, voffB);
            PG8_WAIT_V(6); PG8_BAR; PG8_MMA(1, 1, At, B1); PG8_BAR;
            PG8_LDB(B0, 1, 0); PG8_SCHED; PG8_LDA(At, 1, 0); PG8_STAGE(PG8_SA(0, 1), a2 + hstep, voffA);
            PG8_WAIT_L(8); PG8_BAR; PG8_WAIT_L(0); PG8_MMA(0, 0, At, B0); PG8_BAR; PG8_SCHED;
            PG8_LDB(B1, 1, 1); PG8_STAGE(PG8_SB(1, 0), b3, voffB);
            PG8_BAR; PG8_WAIT_L(0); PG8_MMA(0, 1, At, B1); PG8_BAR;
            PG8_LDA(At, 1, 1); PG8_STAGE(PG8_SA(1, 0), a3, voffA);
            PG8_BAR; PG8_WAIT_L(0); PG8_MMA(1, 0, At, B0); PG8_BAR; PG8_SCHED;
            PG8_STAGE(PG8_SB(1, 1), b3 + hstep, voffB);
            PG8_WAIT_V(6); PG8_BAR; PG8_MMA(1, 1, At, B1); PG8_BAR;
            }
        }
        if constexpr (ALIGN_EPI) { if (wr == 0) PG8_BAR; }
        if constexpr (!Epi::AFTER_DRAIN) { E(acc, cur, wr, wc, fr, fq); S.done(cur); }
        if (!has_next) break;
#pragma unroll
        for (int a = 0; a < 2; ++a)
#pragma unroll
            for (int b = 0; b < 2; ++b)
#pragma unroll
                for (int m = 0; m < 4; ++m)
#pragma unroll
                    for (int n = 0; n < 2; ++n) acc[a][b][m][n] = (f32x4){0.f, 0.f, 0.f, 0.f};
        cur = nxt; cA = nA; cB = nB; ++ui;
        if constexpr (ALIGN_EPI) { if (wr == 1) PG8_BAR; }
    }
    PG8_WAIT_V(0);
    if constexpr (!ALIGN_EPI) { if (wr == 0) PG8_BAR; }
    PG8_BAR;
    if constexpr (Epi::AFTER_DRAIN) { E.fused(acc, cur, wr, wc, fr, fq, lds, wid, lane); S.done(cur); }
#undef PG8_SA
#undef PG8_SB
#undef PG8_STAGE
#undef PG8_LDA
#undef PG8_LDB
#undef PG8_MMA
#undef PG8_WAIT_V
#undef PG8_WAIT_L
#undef PG8_BAR
#undef PG8_SCHED
}
}
#include <hip/hip_bf16.h>
#include <cmath>
namespace attn_body {
using bf16=__hip_bfloat16;
using bf16x8=__attribute__((ext_vector_type(8)))short;
using s16x4=__attribute__((ext_vector_type(4)))short;
using f32x16=__attribute__((ext_vector_type(16)))float;
using u32x4=__attribute__((ext_vector_type(4)))unsigned;
constexpr int BATCH=8,NHEAD=16,SEQ=4096,D=64,PQ=512,PO=1024;
constexpr int NW=8,QBLK=32,QB=QBLK*NW,KVBLK=64,NQB=SEQ/QB;
constexpr int ATTN_UNIT_ROWS=QB;
__device__ __forceinline__ int crow(int r,int hi){return (r&3)+8*(r>>2)+4*hi;}
#define SBAR() __builtin_amdgcn_sched_barrier(0)
__device__ __forceinline__ void cmask(f32x16&p0,f32x16&p1,int jb,int qrel,int hi){
  const float NEG=-INFINITY; int kb=64*jb+4*hi;
  #pragma unroll
  for(int r=0;r<16;++r){int kv=kb+(r&3)+8*(r>>2); if(kv>qrel)p0[r]=NEG; if(kv+32>qrel)p1[r]=NEG;}
}

constexpr int NSLOT=3, SLOTB=8192;
constexpr int LDS_K=0, LDS_V=NSLOT*SLOTB, LDS_WS=2*NSLOT*SLOTB, LDS_OST=LDS_WS+NW*64*4, LDS_BYTES=LDS_OST+NW*4096;
constexpr float C2=0.125f*1.4426950408889634f;
__device__ __forceinline__ void glds16(const void*sbase,unsigned voff,unsigned lds_dst){unsigned keep;
  asm volatile("s_mov_b32 %0, m0\n\ts_mov_b32 m0, %3\n\ts_nop 3\n\tglobal_load_lds_dwordx4 %1, %2\n\ts_mov_b32 m0, %0":"=&s"(keep):"v"(voff),"s"(sbase),"s"(lds_dst):"memory");}
__device__ __forceinline__ float max3f(float a,float b,float c){float r;asm("v_max3_f32 %0, %1, %2, %3":"=v"(r):"v"(a),"v"(b),"v"(c));return r;}
__device__ __forceinline__ float max2f(float a,float b){float r;asm("v_max_f32_e32 %0, %1, %2":"=v"(r):"v"(a),"v"(b));return r;}
__device__ __forceinline__ float fadd_s(float a,float b){float r;asm("v_add_f32_e32 %0, %1, %2":"=v"(r):"v"(a),"v"(b));return r;}
__device__ __forceinline__ float fsub_s(float a,float b){float r;asm("v_sub_f32_e32 %0, %1, %2":"=v"(r):"v"(a),"v"(b));return r;}
typedef float f32x2_t __attribute__((ext_vector_type(2))); typedef __bf16 bf16x2_t __attribute__((ext_vector_type(2)));
__device__ __forceinline__ unsigned cvtpk_s(float lo,float hi){f32x2_t v={lo,hi};bf16x2_t b=__builtin_convertvector(v,bf16x2_t);return __builtin_bit_cast(unsigned,b);}
#define WAIT_BAR(N) asm volatile("s_waitcnt vmcnt(" #N ") lgkmcnt(0)\n\ts_barrier":::"memory")

__device__ __forceinline__ void qkt(f32x16&p0,f32x16&p1,const char*Kslot,const bf16x8*qr,const f32x16&negm,int r32,int hi){
  const char*kb=Kslot+hi*1024+r32*16;
  #pragma unroll
  for(int d0=0;d0<4;++d0){
    const bf16x8 b0=*reinterpret_cast<const bf16x8*>(kb+d0*2048);
    const bf16x8 b1=*reinterpret_cast<const bf16x8*>(kb+d0*2048+512);
    if(d0==0){p0=__builtin_amdgcn_mfma_f32_32x32x16_bf16(b0,qr[0],negm,0,0,0);p1=__builtin_amdgcn_mfma_f32_32x32x16_bf16(b1,qr[0],negm,0,0,0);}
    else{p0=__builtin_amdgcn_mfma_f32_32x32x16_bf16(b0,qr[d0],p0,0,0,0);p1=__builtin_amdgcn_mfma_f32_32x32x16_bf16(b1,qr[d0],p1,0,0,0);}}
}
typedef __attribute__((address_space(3))) const char* lds_cptr;
typedef short v4i16_t __attribute__((ext_vector_type(4)));
__device__ __forceinline__ void kload8(bf16x8*kf,lds_cptr kp){
  kf[0]=*(const __attribute__((address_space(3))) bf16x8*)(kp);      kf[1]=*(const __attribute__((address_space(3))) bf16x8*)(kp+512);
  kf[2]=*(const __attribute__((address_space(3))) bf16x8*)(kp+2048); kf[3]=*(const __attribute__((address_space(3))) bf16x8*)(kp+2560);
  kf[4]=*(const __attribute__((address_space(3))) bf16x8*)(kp+4096); kf[5]=*(const __attribute__((address_space(3))) bf16x8*)(kp+4608);
  kf[6]=*(const __attribute__((address_space(3))) bf16x8*)(kp+6144); kf[7]=*(const __attribute__((address_space(3))) bf16x8*)(kp+6656);
}
__device__ __forceinline__ void kload2(bf16x8*kf,lds_cptr kp,int j){ kf[2*j]=*(const __attribute__((address_space(3))) bf16x8*)(kp+j*2048); kf[2*j+1]=*(const __attribute__((address_space(3))) bf16x8*)(kp+j*2048+512); }
__device__ __forceinline__ s16x4 vtr(lds_cptr p){ return __builtin_bit_cast(s16x4,__builtin_amdgcn_ds_read_tr16_b64_v4i16((__attribute__((address_space(3))) v4i16_t*)p)); }
__device__ __forceinline__ float rowmax(const f32x16&p0,const f32x16&p1){
  float a=max3f(p0[0],p0[1],p1[0]),b=max3f(p0[2],p0[3],p1[1]);a=max3f(a,p1[2],p1[3]);
  #pragma unroll
  for(int r=4;r<16;r+=4){a=max3f(a,p0[r],p0[r+1]);b=max3f(b,p0[r+2],p0[r+3]);a=max3f(a,p1[r],p1[r+1]);b=max3f(b,p1[r+2],p1[r+3]);}
  const float m=max2f(a,b);
  auto rr=__builtin_amdgcn_permlane32_swap(__float_as_uint(m),__float_as_uint(m),false,false);
  return max2f(__uint_as_float(rr[0]),__uint_as_float(rr[1]));
}
__device__ __forceinline__ void pv(f32x16*o,int vb,bf16x8 pa0,bf16x8 pa1,bf16x8 pa2,bf16x8 pa3){
  #pragma unroll
  for(int d0=0;d0<2;++d0){s16x4 lo[4],hi[4];
    #pragma unroll
    for(int ks=0;ks<4;++ks){
      asm volatile("ds_read_b64_tr_b16 %0,%1 offset:%c2":"=&v"(lo[ks]):"v"(vb),"i"(d0*4096+ks*1024):"memory");
      asm volatile("ds_read_b64_tr_b16 %0,%1 offset:%c2":"=&v"(hi[ks]):"v"(vb),"i"(d0*4096+ks*1024+512):"memory");}
    asm volatile("s_waitcnt lgkmcnt(0)":::"memory");SBAR();
    #define PK(k) (bf16x8){lo[k][0],lo[k][1],lo[k][2],lo[k][3],hi[k][0],hi[k][1],hi[k][2],hi[k][3]}
    o[d0]=__builtin_amdgcn_mfma_f32_32x32x16_bf16(pa0,PK(0),o[d0],0,0,0);
    o[d0]=__builtin_amdgcn_mfma_f32_32x32x16_bf16(pa1,PK(1),o[d0],0,0,0);
    o[d0]=__builtin_amdgcn_mfma_f32_32x32x16_bf16(pa2,PK(2),o[d0],0,0,0);
    o[d0]=__builtin_amdgcn_mfma_f32_32x32x16_bf16(pa3,PK(3),o[d0],0,0,0);
    #undef PK
  }
}

#ifndef ATTN_STORE16
#define ATTN_STORE16(p,v) (*(u32x4*)(p)=(v))
#endif
template<int THRL> __device__ __forceinline__ void attn_unit(int tid,int b,int vh,int qb,const bf16*Q,const bf16*__restrict__ K,const bf16*__restrict__ V,bf16*O,char*shm){
  const int hh_=vh>>2,mp_=(vh>>1)&1,vhf_=vh&1; const int qkcol=(hh_*2+mp_)*64,vcol=hh_*128+vhf_*64,ocol=mp_*512+hh_*128+vhf_*64;
  const int lane=tid&63,r32=lane&31,hi=lane>>5; const int wid=__builtin_amdgcn_readfirstlane(tid>>6);
  const long rowbase=(long)b*SEQ; const int q0=qb*QB;
  const bf16*Qw=Q+(rowbase+q0+wid*QBLK)*PQ+qkcol;
  const bf16*Kh=K+rowbase*PQ+qkcol,*Vh=V+rowbase*PQ+vcol;
  const unsigned lds0=(unsigned)(uintptr_t)shm;
  float*wsf=(float*)(shm+LDS_WS)+wid*64;
  const unsigned koff=(unsigned)(lane*PQ+wid*8)*2u;
  const unsigned voff=(unsigned)((16*(wid&3)+(lane>>2))*PQ+(wid>>2)*32+(lane&3)*8)*2u;
  const unsigned kdst=lds0+LDS_K+wid*1024, vdst=lds0+LDS_V+wid*1024;
  #define DMA_K(t,slot) glds16(Kh+(long)(t)*KVBLK*PQ,koff,(unsigned)__builtin_amdgcn_readfirstlane(kdst+(slot)))
  #define DMA_V(t,slot) glds16(Vh+(long)(t)*KVBLK*PQ,voff,(unsigned)__builtin_amdgcn_readfirstlane(vdst+(slot)))
  const int vb0=(int)(lds0+LDS_V)+((lane>>4)&1)*32+(lane&3)*8+(4*hi+((lane&15)>>2))*64;
  const char*Kbase=shm+LDS_K; bf16x8 kf[8];
  const lds_cptr shm3=(lds_cptr)shm; const lds_cptr kp0=shm3+LDS_K+hi*1024+r32*16; const lds_cptr vp0=shm3+LDS_V+((lane>>4)&1)*32+(lane&3)*8+(4*hi+((lane&15)>>2))*64;
  const int NT=(q0+QB)/KVBLK;
  DMA_K(0,0);DMA_V(0,0);DMA_K(1,SLOTB);
  bf16x8 qr[4];
  { int lq_=lane; asm volatile("":"+v"(lq_)); const unsigned qoff_=(unsigned)((lq_&31)*PQ+(lq_>>5)*8);
  _Pragma("unroll") for(int d0=0;d0<4;++d0)qr[d0]=*reinterpret_cast<const bf16x8*>(Qw+qoff_+d0*16); }
  float mhat=0.f,l_reg=0.f;f32x16 o[2];o[0]=f32x16{};o[1]=f32x16{};f32x16 negm=f32x16{};asm volatile("":"+v"(negm));
  const int qrel=wid*QBLK+r32;
  #define CMASK(P0,P1,t) do{int jb_=(t)-(NT-4); if(jb_>=0)cmask(P0,P1,jb_,qrel,hi);}while(0)
  bool resc=false;
  #define START(P0,P1) do{ const float rm=rowmax(P0,P1); resc=false; \
    { const float dl=rm; mhat=fadd_s(mhat,dl); \
      _Pragma("unroll") for(int r=0;r<16;++r){P0[r]=fsub_s(P0[r],dl);P1[r]=fsub_s(P1[r],dl);} \
      _Pragma("unroll") for(int r=0;r<16;++r)negm[r]=-mhat; asm volatile("":"+v"(negm)); } \
    _Pragma("unroll") for(int r=0;r<16;++r)P0[r]=__builtin_amdgcn_exp2f(P0[r]); }while(0)
  #define RESC() do{ if(resc){ asm volatile("s_waitcnt lgkmcnt(0)":::"memory"); \
      _Pragma("unroll") for(int d_=0;d_<2;++d_) _Pragma("unroll") for(int r=0;r<16;++r)o[d_][r]*=wsf[crow(r,hi)]; } }while(0)
  f32x16 pA0,pA1,pB0,pB1;
  int sl_prev=0,sl_cur=0,sl_next=SLOTB;
  #define ROT() do{sl_prev=sl_cur;sl_cur=sl_next;sl_next=(sl_next==(NSLOT-1)*SLOTB)?0:sl_next+SLOTB;}while(0)
  DMA_K(2,2*SLOTB);
  WAIT_BAR(3);
  qkt(pA0,pA1,Kbase,qr,negm,r32,hi);asm volatile("s_nop 15\n\ts_nop 7":"+v"(pA0),"+v"(pA1));CMASK(pA0,pA1,0);
  START(pA0,pA1);
  _Pragma("unroll") for(int r=0;r<16;++r)pA1[r]=__builtin_amdgcn_exp2f(pA1[r]);
  WAIT_BAR(0);
  DMA_K(3,0);DMA_V(1,SLOTB);
  ROT();
  kload8(kf,kp0+sl_cur);
  WAIT_BAR(2);
  s16x4 vlo[8],vhi[8]; u32x4 pw0,pw1,pw2,pw3;
  #define PKW(P,B) cvtpk_s(P[B],P[B+1])
  #define PAF(k) __builtin_bit_cast(bf16x8,pw##k)
  #define VFR(i) (bf16x8){vlo[i][0],vlo[i][1],vlo[i][2],vlo[i][3],vhi[i][0],vhi[i][1],vhi[i][2],vhi[i][3]}
  #define PIN(x) asm volatile("":"+v"(x))
  #define MX3(a,b,c) __builtin_fmaxf(__builtin_fmaxf((a),(b)),(c))
  #define GAPA(MF,A0,A1,A2,A3,W0,W1,PW) do{ MF; sacc+=A0; sacc+=A1; sacc+=A2; sacc+=A3; PIN(sacc); W0; W1; PIN(PW); SBAR(); }while(0)
  #define EX(v) __builtin_amdgcn_exp2f(v)
  #define GAPB(MF,X,B) do{ MF; X[B]=EX(X[B]); X[B+1]=EX(X[B+1]); X[B+2]=EX(X[B+2]); X[B+3]=EX(X[B+3]); PIN(X); SBAR(); }while(0)
  #define VRD(i) do{ vlo[i]=vtr(vp_+(((i)>>2)*4096+((i)&3)*1024)); vhi[i]=vtr(vp_+(((i)>>2)*4096+((i)&3)*1024+512)); }while(0)
  #define KRD(G,j) do{ if(G){ kload2(kf,kp0+sl_next,j); SBAR(); } }while(0)
  #define STEP(C0,C1,P0,P1,t,GK,GV,GL) do{ SBAR(); \
    const lds_cptr vp_=vp0+sl_prev; \
    VRD(0); SBAR(); float sacc=(P0[0]+P0[1]); \
    GAPA(C0=__builtin_amdgcn_mfma_f32_32x32x16_bf16(kf[0],qr[0],negm,0,0,0), P0[2],P0[3],P0[4],P0[5],     pw0[0]=PKW(P0,0), pw0[1]=PKW(P0,2), pw0); \
    VRD(4); SBAR(); GAPA(C1=__builtin_amdgcn_mfma_f32_32x32x16_bf16(kf[1],qr[0],negm,0,0,0), P0[6],P0[7],P0[8],P0[9],     pw0[2]=PKW(P0,4), pw0[3]=PKW(P0,6), pw0); \
    VRD(1); SBAR(); GAPA(C0=__builtin_amdgcn_mfma_f32_32x32x16_bf16(kf[2],qr[1],C0,0,0,0),   P0[10],P0[11],P0[12],P0[13], pw1[0]=PKW(P0,8), pw1[1]=PKW(P0,10), pw1); \
    VRD(5); SBAR(); GAPA(C1=__builtin_amdgcn_mfma_f32_32x32x16_bf16(kf[3],qr[1],C1,0,0,0),   P0[14],P0[15],P1[0],P1[1],   pw1[2]=PKW(P0,12),pw1[3]=PKW(P0,14), pw1); \
    VRD(2); SBAR(); GAPA(C0=__builtin_amdgcn_mfma_f32_32x32x16_bf16(kf[4],qr[2],C0,0,0,0),   P1[2],P1[3],P1[4],P1[5],     pw2[0]=PKW(P1,0), pw2[1]=PKW(P1,2), pw2); \
    VRD(6); SBAR(); GAPA(C1=__builtin_amdgcn_mfma_f32_32x32x16_bf16(kf[5],qr[2],C1,0,0,0),   P1[6],P1[7],P1[8],P1[9],     pw2[2]=PKW(P1,4), pw2[3]=PKW(P1,6), pw2); \
    VRD(3); SBAR(); GAPA(C0=__builtin_amdgcn_mfma_f32_32x32x16_bf16(kf[6],qr[3],C0,0,0,0),   P1[10],P1[11],P1[12],P1[13], pw3[0]=PKW(P1,8), pw3[1]=PKW(P1,10), pw3); \
    VRD(7); SBAR(); GAPA(C1=__builtin_amdgcn_mfma_f32_32x32x16_bf16(kf[7],qr[3],C1,0,0,0),   P1[14],P1[15],0.f,0.f,       pw3[2]=PKW(P1,12),pw3[3]=PKW(P1,14), pw3); \
    l_reg+=sacc; \
    if(GK){DMA_K((t)+3,sl_cur);} if(GV){DMA_V((t)+1,sl_next);} \
    CMASK(C0,C1,t); \
    { float a=MX3(C0[0],C0[1],C1[0]),b=MX3(C0[2],C0[3],C1[1]); a=MX3(a,C1[2],C1[3]); \
      _Pragma("unroll") for(int r=4;r<16;r+=4){a=MX3(a,C0[r],C0[r+1]);b=MX3(b,C0[r+2],C0[r+3]);a=MX3(a,C1[r],C1[r+1]);b=MX3(b,C1[r+2],C1[r+3]);} \
      float rm=__builtin_fmaxf(a,b); { auto rr=__builtin_amdgcn_permlane32_swap(__float_as_uint(rm),__float_as_uint(rm),false,false); rm=__builtin_fmaxf(__uint_as_float(rr[0]),__uint_as_float(rr[1])); } \
      resc=false; \
      if(__builtin_expect(__any(rm>(float)THRL),0)){ const float dl=__builtin_fmaxf(rm,0.f); mhat+=dl; \
        _Pragma("unroll") for(int r=0;r<16;++r){C0[r]-=dl;C1[r]-=dl;} \
        _Pragma("unroll") for(int r=0;r<16;++r)negm[r]=-mhat; asm volatile("":"+v"(negm)); \
        const float f=__builtin_amdgcn_exp2f(-dl); l_reg*=f; if(hi==0)wsf[r32]=f; resc=true; } } \
    SBAR(); \
    GAPB(o[0]=__builtin_amdgcn_mfma_f32_32x32x16_bf16(PAF(0),VFR(0),o[0],0,0,0), C0,0); \
    GAPB(o[1]=__builtin_amdgcn_mfma_f32_32x32x16_bf16(PAF(0),VFR(4),o[1],0,0,0), C0,4); \
    KRD(GL,0); GAPB(o[0]=__builtin_amdgcn_mfma_f32_32x32x16_bf16(PAF(1),VFR(1),o[0],0,0,0), C0,8); \
    KRD(GL,1); GAPB(o[1]=__builtin_amdgcn_mfma_f32_32x32x16_bf16(PAF(1),VFR(5),o[1],0,0,0), C0,12); \
    KRD(GL,2); GAPB(o[0]=__builtin_amdgcn_mfma_f32_32x32x16_bf16(PAF(2),VFR(2),o[0],0,0,0), C1,0); \
    KRD(GL,3); GAPB(o[1]=__builtin_amdgcn_mfma_f32_32x32x16_bf16(PAF(2),VFR(6),o[1],0,0,0), C1,4); \
    GAPB(o[0]=__builtin_amdgcn_mfma_f32_32x32x16_bf16(PAF(3),VFR(3),o[0],0,0,0), C1,8); \
    GAPB(o[1]=__builtin_amdgcn_mfma_f32_32x32x16_bf16(PAF(3),VFR(7),o[1],0,0,0), C1,12); \
    }while(0)
  int t=1;
  #undef CMASK
  #define CMASK(P0,P1,t) do{}while(0)
  for(;t+5<NT;t+=2){
    STEP(pB0,pB1,pA0,pA1,t,true,true,true);     WAIT_BAR(2); RESC(); ROT();
    STEP(pA0,pA1,pB0,pB1,t+1,true,true,true);   WAIT_BAR(2); RESC(); ROT();
  }
  #undef CMASK
  #define CMASK(P0,P1,t) do{int jb_=(t)-(NT-4); if(jb_>=0)cmask(P0,P1,jb_,qrel,hi);}while(0)
  #define ENDW(tt) do{ if((tt)+3<NT){WAIT_BAR(2);} else if((tt)+2<NT){WAIT_BAR(1);} else {WAIT_BAR(0);} }while(0)
  for(;t+1<NT;t+=2){
    STEP(pB0,pB1,pA0,pA1,t,(t+3<NT),(t+1<NT),(t+1<NT));       ENDW(t);   RESC(); ROT();
    STEP(pA0,pA1,pB0,pB1,t+1,(t+4<NT),(t+2<NT),(t+2<NT));     ENDW(t+1); RESC(); ROT();
  }
  STEP(pB0,pB1,pA0,pA1,NT-1,false,false,false); RESC();
  { float sacc=pB0[0]+pB0[1]; _Pragma("unroll") for(int r=2;r<16;++r)sacc+=pB0[r]; _Pragma("unroll") for(int r=0;r<16;++r)sacc+=pB1[r]; l_reg+=sacc;
    pw0=(u32x4){PKW(pB0,0),PKW(pB0,2),PKW(pB0,4),PKW(pB0,6)};pw1=(u32x4){PKW(pB0,8),PKW(pB0,10),PKW(pB0,12),PKW(pB0,14)};pw2=(u32x4){PKW(pB1,0),PKW(pB1,2),PKW(pB1,4),PKW(pB1,6)};pw3=(u32x4){PKW(pB1,8),PKW(pB1,10),PKW(pB1,12),PKW(pB1,14)};
    SBAR(); pv(o,vb0+sl_cur,PAF(0),PAF(1),PAF(2),PAF(3)); }
  #undef PKW
  #undef PAF
  #undef VFR
  #undef PIN
  #undef MX3
  #undef GAPA
  #undef GAPB
  #undef EX
  #undef VRD
  #undef KRD
  #undef STEP
  #undef ENDW
  {auto rr=__builtin_amdgcn_permlane32_swap(__float_as_uint(l_reg),__float_as_uint(l_reg),false,false);l_reg=__uint_as_float(rr[0])+__uint_as_float(rr[1]);}
  if(hi==0)wsf[32+r32]=l_reg;asm volatile("s_waitcnt lgkmcnt(0)":::"memory");
  float rli[16];
  #pragma unroll
  for(int r=0;r<16;++r)rli[r]=__builtin_amdgcn_rcpf(wsf[32+crow(r,hi)]);
  bf16*Ow=O+(rowbase+q0+wid*QBLK)*PO+ocol;
  { bf16*stg=(bf16*)(shm+LDS_OST)+wid*2048;
    #pragma unroll
    for(int r=0;r<16;++r){const int orow=crow(r,hi);
      #pragma unroll
      for(int d0=0;d0<2;++d0)stg[orow*64+d0*32+r32]=__float2bfloat16(o[d0][r]*rli[r]);}
    asm volatile("s_waitcnt lgkmcnt(0)":::"memory");
    { int lo_=lane; asm volatile("":"+v"(lo_)); const unsigned ooff_=(unsigned)((lo_>>3)*PO+(lo_&7)*8);
    _Pragma("unroll") for(int i=0;i<4;++i){const int row=i*8+(lane>>3),ch=lane&7; const u32x4 v=*(const u32x4*)(stg+row*64+ch*8); ATTN_STORE16(Ow+ooff_+i*8*PO,v);} } }
  asm volatile("s_waitcnt lgkmcnt(0)\n\ts_barrier":::"memory");
  #undef DMA_K
  #undef DMA_V
  #undef CMASK
  #undef START
  #undef RESC
  #undef ROT
}
constexpr int ATTN_LDS_BYTES=LDS_BYTES;
struct AttnTensors { const bf16* Q; const bf16* K; const bf16* V; bf16* O; };
template<int THRL=8> __device__ __forceinline__ void attn_phase(char*lds,const AttnTensors&T,int vcu,int G,const int tid){
  for(int slot=vcu;slot<256;slot+=G){ const int pair=slot>>1,s=slot&1,b=pair>>4,vh=pair&15;
    for(int j=7;j>=0;--j){ const int qb=2*j+((j&1)^s); attn_unit<THRL>(tid,b,vh,qb,T.Q,T.K,T.V,T.O,lds); } }
}
#undef SBAR
#undef WAIT_BAR
}
namespace cg = cooperative_groups;
#define GAS __attribute__((address_space(1)))
#define LAS __attribute__((address_space(3)))
typedef unsigned short bf16;
typedef unsigned v4u __attribute__((ext_vector_type(4)));
typedef unsigned v2u __attribute__((ext_vector_type(2)));
typedef float f32x4 __attribute__((ext_vector_type(4)));
typedef short bf16x8 __attribute__((ext_vector_type(8)));

constexpr int NB = 8, SEQ = 4096, M = NB * SEQ, DMODEL = 1024, DEPTH = 2;
constexpr int D_SGU = 512, D_ATT = 512, D_IN = 2560, D_FF = 2816, NUP = 2 * D_FF;
constexpr float EPS = 1e-6f;
constexpr float C2 = 0.125f * 1.4426950408889634f;
constexpr size_t MiB = 1u << 20;
constexpr size_t WS_W = 1 * MiB, W_LAYER = 24 * MiB;
constexpr size_t W_IN = 0, W_OUT = 5 * MiB, W_UP = 7 * MiB, W_DN = 18 * MiB;
constexpr size_t WS_COS = 49 * MiB, WS_SIN = 50 * MiB;
constexpr size_t WS_PART = 51 * MiB;
constexpr size_t WS_TOP = 53 * MiB, WS_BOT = 75 * MiB;
constexpr size_t WS_HB = 97 * MiB;
constexpr size_t WS_MIX = 161 * MiB;
constexpr size_t WS_R = 225 * MiB;
constexpr size_t SEG = (size_t)M * 512;
constexpr size_t WS_O = WS_R + 5 * SEG * 2;
constexpr size_t WS_END = WS_O + (size_t)M * 1024 * 2;
static_assert(WS_END == 449 * MiB && WS_R + (size_t)M * D_FF * 2 <= WS_END, "d_ws map");
constexpr size_t WS_CTL = 0; constexpr int CW_BAR = 4096;
constexpr int MISC_OFF = 131072 + 320;
constexpr int LDS_BYTES = 147456;
constexpr int NPH = 16;

__device__ __forceinline__ float bf2f(unsigned b) { return __uint_as_float(b << 16); }
__device__ __forceinline__ unsigned pk2(float lo, float hi) { return pg8::cvt_pk_bf16(lo, hi); }
__device__ __forceinline__ float shx(float v, int lane, int mask) { return __int_as_float(__builtin_amdgcn_ds_bpermute(4 * (lane ^ mask), __float_as_int(v))); }
__device__ __forceinline__ float wave_sum(float v, int lane) {
#pragma unroll
    for (int o = 1; o < 64; o <<= 1) v += shx(v, lane, o);
    return v;
}
#define LDS_WAIT() asm volatile("s_waitcnt lgkmcnt(0)" ::: "memory")

#define RLX_AGENT __ATOMIC_RELAXED, __HIP_MEMORY_SCOPE_AGENT
#define XB_TMO      128
#define XB_XCNT(j)  (256  + 64 * (j))
#define XB_XSUB(j)  (1280 + 64 * (j))
#define XB_XGEN(j)  (2304 + 64 * (j))
#define XB_TOP      3328
#define XB_TOPGEN   3392
#define XCD_BAR_WORDS 3456
#define XB_SPIN_CAP (1u << 18)

__device__ __forceinline__ unsigned xb_ld(unsigned* p)              { return __hip_atomic_load(p, __ATOMIC_RELAXED, __HIP_MEMORY_SCOPE_AGENT); }
__device__ __forceinline__ unsigned xb_add(unsigned* p, unsigned v) { return __hip_atomic_fetch_add(p, v, __ATOMIC_RELAXED, __HIP_MEMORY_SCOPE_AGENT); }
__device__ __forceinline__ unsigned xb_xcc_id() { return (unsigned)__builtin_amdgcn_s_getreg((3 << 11) | 20) & 0xFu; }
#define XB_SPIN(cond, bar) do { unsigned _sp = 0; while (cond) { __builtin_amdgcn_s_sleep(1); \
    if ((++_sp & 255u) == 0u) { if (xb_ld(&(bar)[XB_TMO])) break; if (_sp > XB_SPIN_CAP) { atomicAdd(&(bar)[XB_TMO], 1u); break; } } } } while (0)

struct XcdBarrier {
    unsigned* bar; unsigned x;
    volatile LAS unsigned* st;
};

__device__ __forceinline__ XcdBarrier xcd_barrier_post(unsigned* bar, volatile LAS unsigned* st, bool is_t0) {
    XcdBarrier b; b.bar = bar; b.x = xb_xcc_id(); b.st = st;
    if (is_t0) (void)xb_add(&bar[XB_XCNT(b.x)], 1u);
    return b;
}
__device__ __forceinline__ void xcd_barrier_complete(unsigned* bar, unsigned x, unsigned& nloc, unsigned& nx) {
    const unsigned G = gridDim.x * gridDim.y * gridDim.z;
    unsigned sum, cnt, mine, sp = 0u;
    for (;;) {
        sum = 0u; cnt = 0u; mine = 0u;
#pragma unroll
        for (unsigned j = 0; j < 16; ++j) { const unsigned c = xb_ld(&bar[XB_XCNT(j)]); sum += c; cnt += (c > 0u) ? 1u : 0u; mine = (j == x) ? c : mine; }
        if (sum == G) break;
        __builtin_amdgcn_s_sleep(1);
        if ((++sp & 255u) == 0u) { if (xb_ld(&bar[XB_TMO])) break; if (sp > XB_SPIN_CAP) { atomicAdd(&bar[XB_TMO], 1u); break; } }
    }
    nloc = mine > 0u ? mine : 1u; nx = cnt > 0u ? cnt : 1u;
}

__device__ __forceinline__ void xcd_barrier(const XcdBarrier& b, bool is_t0) {
    asm volatile("s_waitcnt vmcnt(0)" ::: "memory");
    __syncthreads();
    if (is_t0) {
        unsigned* bar = b.bar;
        __builtin_amdgcn_s_waitcnt(0);
        unsigned nloc = b.st[0], nx = b.st[1];
        if (nloc == 0u) { xcd_barrier_complete(bar, b.x, nloc, nx); b.st[0] = nloc; b.st[1] = nx; }
        const unsigned old = xb_add(&bar[XB_XSUB(b.x)], 1u);
        const unsigned gen = old / nloc;
        if (old + 1u == (gen + 1u) * nloc) {
            __builtin_amdgcn_fence(__ATOMIC_RELEASE, "agent");
            asm volatile("s_waitcnt vmcnt(0)" ::: "memory");
            const unsigned og = xb_add(&bar[XB_TOP], 1u);
            const unsigned tg = og / nx;
            if (og + 1u == (tg + 1u) * nx) xb_add(&bar[XB_TOPGEN], 1u);
            else XB_SPIN(xb_ld(&bar[XB_TOPGEN]) == tg, bar);
            __builtin_amdgcn_fence(__ATOMIC_ACQUIRE, "agent");
            xb_add(&bar[XB_XGEN(b.x)], 1u);
            asm volatile("s_waitcnt vmcnt(0)" ::: "memory");
        } else {
            XB_SPIN(xb_ld(&bar[XB_XGEN(b.x)]) == gen, bar);
            __builtin_amdgcn_fence(__ATOMIC_ACQUIRE, "agent");
            asm volatile("s_waitcnt vmcnt(0)" ::: "memory");
        }
    }
    __syncthreads();
}


template <int MODE> __device__ __forceinline__ int wrow_map(int n) {
    if (MODE == 1) { if (n >= 1024 && n < 2048) { const int d = n & 63; if (d < 16) return (n - d) + (d < 8 ? 2 * d : 2 * (d - 8) + 1); } return n; }
    if (MODE == 2) { return n < D_FF ? (n >> 7) * 256 + (n & 127) : ((n - D_FF) >> 7) * 256 + 128 + ((n - D_FF) & 127); }
    return n;
}
template <int MODE> __device__ __forceinline__ void p0_transpose_item(const float* W, int K, int N, bf16* WT, LAS float* scr, int item, int lane) {
    const int nblk = N / 32, kb = item / nblk, nb = item % nblk, k0 = 64 * kb, n0 = 32 * nb;
#pragma unroll 8
    for (int i = 0; i < 32; ++i) { const int kk = 2 * i + (lane >> 5); scr[kk * 33 + (lane & 31)] = W[(size_t)(k0 + kk) * N + n0 + (lane & 31)]; }
    LDS_WAIT(); asm volatile("" ::: "memory");
    const int c = lane & 7;
#pragma unroll
    for (int j = 0; j < 4; ++j) { const int n = (lane >> 3) + 8 * j; const LAS float* s = scr + (8 * c) * 33 + n;
        v4u o; o.x = pk2(s[0 * 33], s[1 * 33]); o.y = pk2(s[2 * 33], s[3 * 33]); o.z = pk2(s[4 * 33], s[5 * 33]); o.w = pk2(s[6 * 33], s[7 * 33]);
        *(v4u*)(WT + (size_t)wrow_map<MODE>(n0 + n) * K + k0 + 8 * c) = o; }
    LDS_WAIT(); asm volatile("" ::: "memory");
}

__device__ __forceinline__ const void* karg(int i) {
    unsigned off = 8u * (unsigned)i; asm volatile("" : "+s"(off));
    return *(const void* const __attribute__((address_space(4)))*)((const char __attribute__((address_space(4)))*)__builtin_amdgcn_kernarg_segment_ptr() + off);
}
#define KIN(i) ((const float*)karg(i))
#define KOUT() ((float*)karg(19))
#define KWS() ((unsigned char*)karg(20))
#ifndef MK_MASK
#define MK_MASK 0x3ff
#endif
#define HAVE(k) (((MK_MASK) >> (k)) & 1)
#define MK_IDS \
    int zz_; asm volatile("s_mov_b32 %0, 0" : "=s"(zz_)); \
    const int lane = __builtin_amdgcn_mbcnt_hi(~0u, __builtin_amdgcn_mbcnt_lo(~0u, (unsigned)zz_)), wave = wave_s; const int tid = wave * 64 + lane; \
    int G = gridDim.x, bx = blockIdx.x; asm volatile("" : "+s"(G), "+s"(bx)); \
    const int vcu = (G % 8 == 0) ? (bx % 8) * (G / 8) + bx / 8 : bx;     \
    const int gw = vcu * 8 + wave, NGW = G * 8; (void)lane; (void)gw; (void)NGW; (void)vcu; (void)tid;
struct Args { const void* in[19]; float* out; unsigned char* ws; int ph_lo, ph_hi; };

__global__ void __launch_bounds__(512, 2) mk_fwd(Args args) {
    extern __shared__ __attribute__((aligned(16))) unsigned char lds[];
    cg::grid_group grid = cg::this_grid();
    int wave_s; { const int t0_ = threadIdx.x; wave_s = __builtin_amdgcn_readfirstlane(t0_ >> 6); asm volatile("" : "+s"(wave_s));
        if (t0_ < 16) ((volatile LAS unsigned*)((LAS unsigned char*)lds + MISC_OFF))[t0_] = 0u;
        if (blockIdx.x == 0) { unsigned* bw = (unsigned*)(args.ws + WS_CTL) + CW_BAR; for (int i = t0_; i < XCD_BAR_WORDS; i += 512) __hip_atomic_store(bw + i, 0u, __ATOMIC_RELAXED, __HIP_MEMORY_SCOPE_AGENT); }
        __threadfence(); grid.sync(); }
    { const bool t0b_ = (wave_s == 0) && (__builtin_amdgcn_mbcnt_hi(~0u, __builtin_amdgcn_mbcnt_lo(~0u, 0u)) == 0);
      (void)xcd_barrier_post((unsigned*)(args.ws + WS_CTL) + CW_BAR, (volatile LAS unsigned*)((LAS unsigned char*)lds + MISC_OFF) + 8, t0b_); }
    const int lo = args.ph_lo, hi = args.ph_hi;
#define IN(k) (lo <= (k) && (k) < hi)
#define SEAM(k) do { if (IN(k) && IN((k) + 1)) { int zb_; asm volatile("s_mov_b32 %0, 0" : "=s"(zb_)); \
        const bool t0b_ = (wave_s == 0) && (__builtin_amdgcn_mbcnt_hi(~0u, __builtin_amdgcn_mbcnt_lo(~0u, (unsigned)zb_)) == 0); \
        XcdBarrier xb_; xb_.bar = (unsigned*)(KWS() + WS_CTL) + CW_BAR; xb_.x = xb_xcc_id(); xb_.st = (volatile LAS unsigned*)((LAS unsigned char*)lds + MISC_OFF) + 8; xcd_barrier(xb_, t0b_); } } while (0)

    if (HAVE(0) && IN(0)) {
        MK_IDS
        LAS float* scr = (LAS float*)((LAS unsigned char*)lds + wave * 16384);
        unsigned char* ws = KWS(); const float* w_in = KIN(3); const float* w_out = KIN(12); const float* w_up = KIN(14); const float* w_down = KIN(17);
        constexpr int I_IN = (DMODEL / 64) * (D_IN / 32), I_OUT = (DMODEL / 64) * (DMODEL / 32), I_UP = (DMODEL / 64) * (NUP / 32), I_DN = (D_FF / 64) * (DMODEL / 32);
        constexpr int I_L = I_IN + I_OUT + I_UP + I_DN;
        for (int it = gw; it < DEPTH * I_L; it += NGW) {
            const int l = it / I_L; int r = it % I_L; unsigned char* wl = ws + WS_W + (size_t)l * W_LAYER;
            if (r < I_IN) { p0_transpose_item<1>(w_in + (size_t)l * DMODEL * D_IN, DMODEL, D_IN, (bf16*)(wl + W_IN), scr, r, lane); continue; } r -= I_IN;
            if (r < I_OUT) { p0_transpose_item<0>(w_out + (size_t)l * DMODEL * DMODEL, DMODEL, DMODEL, (bf16*)(wl + W_OUT), scr, r, lane); continue; } r -= I_OUT;
            if (r < I_UP) { p0_transpose_item<2>(w_up + (size_t)l * DMODEL * NUP, DMODEL, NUP, (bf16*)(wl + W_UP), scr, r, lane); continue; } r -= I_UP;
            p0_transpose_item<0>(w_down + (size_t)l * D_FF * DMODEL, D_FF, DMODEL, (bf16*)(wl + W_DN), scr, r, lane);
        }
        const float* x = KIN(0); const int* positions = (const int*)karg(1); const float* attn_norm = KIN(2);
        bf16* HB = (bf16*)(ws + WS_HB); float* PART = (float*)(ws + WS_PART); float* COS = (float*)(ws + WS_COS); float* SIN = (float*)(ws + WS_SIN);
        for (int m = gw; m < M; m += NGW) {
            const f32x4* xr = (const f32x4*)(x + (size_t)m * DMODEL) + lane; const f32x4* gr = (const f32x4*)attn_norm + lane;
            unsigned long long* o8 = (unsigned long long*)(HB + (size_t)m * DMODEL) + lane; float s = 0.f;
#pragma unroll
            for (int j = 0; j < 4; ++j) { const f32x4 v = xr[64 * j], g = gr[64 * j]; s += (v.x * v.x + v.y * v.y) + (v.z * v.z + v.w * v.w);
                o8[64 * j] = (unsigned long long)pk2(v.x * g.x, v.y * g.y) | ((unsigned long long)pk2(v.z * g.z, v.w * g.w) << 32); }
            s = wave_sum(s, lane);
            if (lane < 16) PART[(size_t)m * 16 + lane] = (lane == 0) ? s : 0.f;
            if (lane < 8) {
                const float inv_freq = exp2f(-(float)lane * 0.125f * 18.931568569324174f);
                const float ang = (float)positions[m] * inv_freq;
                const double rev = (double)ang * 0.15915494309189535; const float fr = (float)(rev - rint(rev));
                COS[(size_t)m * 8 + lane] = __builtin_amdgcn_cosf(fr); SIN[(size_t)m * 8 + lane] = __builtin_amdgcn_sinf(fr);
            }
        }
    }
    SEAM(0);

    for (int l = 0; l < DEPTH; ++l) {
        const int pb = 1 + 7 * l;
        const float lambda_init = (l == 0) ? 0.2f : 0.35550906759096314f;
        if (HAVE(1) && IN(pb + 0)) {
            MK_IDS
            unsigned char* ws = KWS(); unsigned char* wl = ws + WS_W + (size_t)l * W_LAYER;
            pg8::Gemm g{(const bf16*)(ws + WS_HB), (const bf16*)(wl + W_IN), M, D_IN, DMODEL}; pg8::StaticOrder S; S.init(M, D_IN, G, bx);
            pg8::EpiInProj E{(const float*)(ws + WS_PART), (const float*)(ws + WS_COS), (const float*)(ws + WS_SIN), (bf16*)(ws + WS_R), C2, SEG};
            pg8::gemm_phase<pg8::EpiInProj, pg8::StaticOrder, true, true>((LAS unsigned char*)lds, g, S, E, tid);
        }
        SEAM(pb + 0);
        if (IN(pb + 1)) {
            MK_IDS
            unsigned char* ws = KWS(); bf16* R = (bf16*)(ws + WS_R); bf16* OB = (bf16*)(ws + WS_O); bf16* MIX = (bf16*)(ws + WS_MIX);
            const attn_body::AttnTensors AT{(const attn_body::bf16*)(R + 2 * SEG), (const attn_body::bf16*)(R + 3 * SEG), (const attn_body::bf16*)(R + 4 * SEG), (attn_body::bf16*)OB};
            if (HAVE(2)) attn_body::attn_phase<8>((char*)lds, AT, vcu, G, tid);
            const bf16* U = R; const bf16* VS = R + SEG;
            LAS bf16* vgT = (LAS bf16*)lds;
            const float* Wg_l = KIN(5) + (size_t)l * 4 * 128 * 128; const float* bs_l = KIN(6) + (size_t)l * 4 * 128; const float* vn_l = KIN(4) + (size_t)l * D_SGU;
            if (HAVE(3)) for (int unit = vcu; unit < NB * 32 * 4; unit += G) {
                const int g = unit & 3, ck = (unit >> 2) & 31, b = unit >> 7; const int t0 = b * SEQ + ck * 128;
                {
                    const int dch = tid & 15; f32x4 ga = *(const f32x4*)(vn_l + g * 128 + 8 * dch), gb = *(const f32x4*)(vn_l + g * 128 + 8 * dch + 4);
#pragma unroll
                    for (int i = 0; i < 4; ++i) { const int q = (tid >> 4) + 32 * i;
                        const v4u raw = *(const v4u*)(VS + (size_t)(t0 + q) * 512 + g * 128 + 8 * dch);
                        float f[8]; f[0] = bf2f(raw.x & 0xffffu); f[1] = bf2f(raw.x >> 16); f[2] = bf2f(raw.y & 0xffffu); f[3] = bf2f(raw.y >> 16); f[4] = bf2f(raw.z & 0xffffu); f[5] = bf2f(raw.z >> 16); f[6] = bf2f(raw.w & 0xffffu); f[7] = bf2f(raw.w >> 16);
                        float ss = 0.f;
#pragma unroll
                        for (int j = 0; j < 8; ++j) ss += f[j] * f[j];
                        ss += shx(ss, lane, 1); ss += shx(ss, lane, 2); ss += shx(ss, lane, 4); ss += shx(ss, lane, 8);
                        const float r = __builtin_amdgcn_rsqf(ss * (1.0f / 128.0f) + EPS);
#pragma unroll
                        for (int j = 0; j < 8; ++j) { const float gj = j < 4 ? ga[j] : gb[j - 4]; vgT[(8 * dch + j) * 136 + q] = (bf16)(pk2(f[j] * r * gj, 0.f) & 0xffffu); }
                    }
                }
                __syncthreads();
                {
                    const int p = 16 * wave + (lane & 15), kq = 8 * (lane >> 4); const int nks = (wave >> 1) + 1;
                    f32x4 acc[8];
#pragma unroll
                    for (int nb = 0; nb < 8; ++nb) acc[nb] = (f32x4){0.f, 0.f, 0.f, 0.f};
                    for (int ks = 0; ks < nks; ++ks) {
                        const int q0 = 32 * ks + kq; const float* wp = Wg_l + ((size_t)g * 128 + p) * 128 + q0;
                        const f32x4 w0 = *(const f32x4*)wp, w1 = *(const f32x4*)(wp + 4);
                        float wf[8] = {w0[0], w0[1], w0[2], w0[3], w1[0], w1[1], w1[2], w1[3]};
#pragma unroll
                        for (int j = 0; j < 8; ++j) if (q0 + j > p) wf[j] = 0.f;
                        v4u wb; wb.x = pk2(wf[0], wf[1]); wb.y = pk2(wf[2], wf[3]); wb.z = pk2(wf[4], wf[5]); wb.w = pk2(wf[6], wf[7]);
                        const bf16x8 bfrag = __builtin_bit_cast(bf16x8, wb);
#pragma unroll
                        for (int nb = 0; nb < 8; ++nb) {
                            const bf16x8 afrag = *(const LAS bf16x8*)(vgT + (16 * nb + (lane & 15)) * 136 + q0);
                            acc[nb] = __builtin_amdgcn_mfma_f32_16x16x32_bf16(afrag, bfrag, acc[nb], 0, 0, 0);
                        }
                    }
                    const float bias = bs_l[g * 128 + p];
#pragma unroll
                    for (int nb = 0; nb < 8; ++nb) { const int d = 16 * nb + 4 * (lane >> 4);
                        const v2u ur = *(const v2u*)(U + (size_t)(t0 + p) * 512 + g * 128 + d);
                        const float y0 = bf2f(ur.x & 0xffffu) * (acc[nb][0] + bias), y1 = bf2f(ur.x >> 16) * (acc[nb][1] + bias), y2 = bf2f(ur.y & 0xffffu) * (acc[nb][2] + bias), y3 = bf2f(ur.y >> 16) * (acc[nb][3] + bias);
                        v2u o; o.x = pk2(y0, y1); o.y = pk2(y2, y3);
                        *(v2u*)(MIX + (size_t)(t0 + p) * 1024 + g * 128 + d) = o; }
                }
                __syncthreads();
            }
        }
        SEAM(pb + 1);
        if (HAVE(4) && IN(pb + 2)) {
            MK_IDS
            unsigned char* ws = KWS(); const bf16* OB = (const bf16*)(ws + WS_O); bf16* MIX = (bf16*)(ws + WS_MIX); const float* subln = KIN(11);
            float d1 = KIN(7)[l * 64 + lane] * KIN(8)[l * 64 + lane], d2 = KIN(9)[l * 64 + lane] * KIN(10)[l * 64 + lane];
            d1 = wave_sum(d1, lane); d2 = wave_sum(d2, lane);
            const float lam = expf(d1) - expf(d2) + lambda_init;
            const f32x4 sa = *(const f32x4*)(subln + l * 128 + 8 * (lane & 15)), sb = *(const f32x4*)(subln + l * 128 + 8 * (lane & 15) + 4);
            const float post = 1.0f - lambda_init;
            for (int m = gw; m < M; m += NGW) {
                const v4u r1 = *(const v4u*)(OB + (size_t)m * 1024 + 8 * lane), r2 = *(const v4u*)(OB + (size_t)m * 1024 + 512 + 8 * lane);
                float d[8];
                d[0] = bf2f(r1.x & 0xffffu) - lam * bf2f(r2.x & 0xffffu); d[1] = bf2f(r1.x >> 16) - lam * bf2f(r2.x >> 16);
                d[2] = bf2f(r1.y & 0xffffu) - lam * bf2f(r2.y & 0xffffu); d[3] = bf2f(r1.y >> 16) - lam * bf2f(r2.y >> 16);
                d[4] = bf2f(r1.z & 0xffffu) - lam * bf2f(r2.z & 0xffffu); d[5] = bf2f(r1.z >> 16) - lam * bf2f(r2.z >> 16);
                d[6] = bf2f(r1.w & 0xffffu) - lam * bf2f(r2.w & 0xffffu); d[7] = bf2f(r1.w >> 16) - lam * bf2f(r2.w >> 16);
                float ss = 0.f;
#pragma unroll
                for (int j = 0; j < 8; ++j) ss += d[j] * d[j];
                ss += shx(ss, lane, 1); ss += shx(ss, lane, 2); ss += shx(ss, lane, 4); ss += shx(ss, lane, 8);
                const float r = __builtin_amdgcn_rsqf(ss * (1.0f / 128.0f) + EPS) * post;
                v4u o; o.x = pk2(d[0] * r * sa[0], d[1] * r * sa[1]); o.y = pk2(d[2] * r * sa[2], d[3] * r * sa[3]); o.z = pk2(d[4] * r * sb[0], d[5] * r * sb[1]); o.w = pk2(d[6] * r * sb[2], d[7] * r * sb[3]);
                *(v4u*)(MIX + (size_t)m * 1024 + 512 + 8 * lane) = o;
            }
        }
        SEAM(pb + 2);
        if (HAVE(5) && IN(pb + 3)) {
            MK_IDS
            unsigned char* ws = KWS(); unsigned char* wl = ws + WS_W + (size_t)l * W_LAYER; float* out = KOUT();
            pg8::Gemm g{(const bf16*)(ws + WS_MIX), (const bf16*)(wl + W_OUT), M, DMODEL, DMODEL}; pg8::StaticOrder S; S.init(M, DMODEL, G, bx);
            pg8::EpiResid E{l == 0 ? KIN(0) : (const float*)out, out, (bf16*)(ws + WS_HB), KIN(13) + (size_t)l * DMODEL, (float*)(ws + WS_PART)};
            pg8::gemm_phase<pg8::EpiResid, pg8::StaticOrder, true, true>((LAS unsigned char*)lds, g, S, E, tid);
        }
        SEAM(pb + 3);
        if (HAVE(6) && IN(pb + 4)) {
            MK_IDS
            unsigned char* ws = KWS(); unsigned char* wl = ws + WS_W + (size_t)l * W_LAYER;
            pg8::Gemm g{(const bf16*)(ws + WS_HB), (const bf16*)(wl + W_UP), M, NUP, DMODEL}; pg8::StaticOrder S; S.init(M, NUP, G, bx);
            pg8::EpiUp E{(const float*)(ws + WS_PART), KIN(15) + (size_t)l * 3 * NUP, KIN(16) + (size_t)l * NUP, (bf16*)(ws + WS_R), (float*)(ws + WS_TOP), (float*)(ws + WS_BOT)};
            pg8::gemm_phase<pg8::EpiUp, pg8::StaticOrder, true, true>((LAS unsigned char*)lds, g, S, E, tid);
        }
        SEAM(pb + 4);
        if (HAVE(7) && IN(pb + 5)) {
            MK_IDS
            unsigned char* ws = KWS(); const float* TOP = (const float*)(ws + WS_TOP); const float* BOT = (const float*)(ws + WS_BOT); bf16* ACT = (bf16*)(ws + WS_R);
            const float* cw = KIN(15) + (size_t)l * 3 * NUP; const float* cb = KIN(16) + (size_t)l * NUP;
            for (int idx = bx * 512 + tid; idx < 512 * 2 * 704; idx += G * 512) {
                const int c = 4 * (idx % 704), rr = (idx / 704) & 1, blk = idx / 1408; const int row = 64 * blk + rr; const bool first = (blk & 63) == 0;
                const float* t1 = TOP + (size_t)(blk * 2 + 1) * 5632 + c; const float* t0 = TOP + (size_t)(blk * 2) * 5632 + c;
                const float* b1 = BOT + (size_t)((blk - 1) * 2 + 1) * 5632 + c; const float* b0 = BOT + (size_t)((blk - 1) * 2) * 5632 + c;
                const f32x4 z = {0.f, 0.f, 0.f, 0.f};
                f32x4 g2, g1, g0, v2, v1, v0;
                if (rr == 1) { g2 = *(const f32x4*)t1; v2 = *(const f32x4*)(t1 + 2816); g1 = *(const f32x4*)t0; v1 = *(const f32x4*)(t0 + 2816); g0 = first ? z : *(const f32x4*)b1; v0 = first ? z : *(const f32x4*)(b1 + 2816); }
                else { g2 = *(const f32x4*)t0; v2 = *(const f32x4*)(t0 + 2816); g1 = first ? z : *(const f32x4*)b1; v1 = first ? z : *(const f32x4*)(b1 + 2816); g0 = first ? z : *(const f32x4*)b0; v0 = first ? z : *(const f32x4*)(b0 + 2816); }
                const f32x4 cg = *(const f32x4*)(cb + c) + *(const f32x4*)(cw + 2 * 5632 + c) * g2 + *(const f32x4*)(cw + 5632 + c) * g1 + *(const f32x4*)(cw + c) * g0;
                const f32x4 cv = *(const f32x4*)(cb + 2816 + c) + *(const f32x4*)(cw + 2 * 5632 + 2816 + c) * v2 + *(const f32x4*)(cw + 5632 + 2816 + c) * v1 + *(const f32x4*)(cw + 2816 + c) * v0;
                v2u o; o.x = pk2(pg8::silu_f(cg[0]) * cv[0], pg8::silu_f(cg[1]) * cv[1]); o.y = pk2(pg8::silu_f(cg[2]) * cv[2], pg8::silu_f(cg[3]) * cv[3]);
                *(v2u*)(ACT + (size_t)row * D_FF + c) = o;
            }
        }
        SEAM(pb + 5);
        if (HAVE(8) && IN(pb + 6)) {
            MK_IDS
            unsigned char* ws = KWS(); unsigned char* wl = ws + WS_W + (size_t)l * W_LAYER; float* out = KOUT();
            pg8::Gemm g{(const bf16*)(ws + WS_R), (const bf16*)(wl + W_DN), M, DMODEL, D_FF}; pg8::StaticOrder S; S.init(M, DMODEL, G, bx);
            pg8::EpiResid E{(const float*)out, out, l + 1 < DEPTH ? (bf16*)(ws + WS_HB) : (bf16*)nullptr, KIN(2) + (size_t)(l + 1 < DEPTH ? l + 1 : 0) * DMODEL, (float*)(ws + WS_PART)};
            pg8::gemm_phase<pg8::EpiResid, pg8::StaticOrder, true, true>((LAS unsigned char*)lds, g, S, E, tid);
        }
        SEAM(pb + 6);
    }
    if (HAVE(9) && IN(15)) {
        MK_IDS
        float* out = KOUT(); const float* final_norm = KIN(18); const float* PART = (const float*)(KWS() + WS_PART);
        for (int m = gw; m < M; m += NGW) {
            const float rs = pg8::row_rs(PART, m);
            f32x4* xr = (f32x4*)(out + (size_t)m * DMODEL) + lane; const f32x4* gr = (const f32x4*)final_norm + lane;
#pragma unroll
            for (int j = 0; j < 4; ++j) { const f32x4 v = xr[64 * j]; xr[64 * j] = v * rs * gr[64 * j]; }
        }
    }
#undef IN
#undef SEAM
}

#ifndef MK_LAST
#define MK_LAST NPH
#endif
#ifndef MK_SPLIT
#define MK_SPLIT 0
#endif
extern "C" void kernel_launch(void* const* d_in, const int* in_sizes, int n_in, void* d_out, int out_size, void* d_ws, size_t ws_size, hipStream_t stream) {
    static int grid = 0;
    if (grid == 0) {
        if (n_in != 19 || in_sizes[0] != M * DMODEL || out_size != M * DMODEL || ws_size < WS_END) {
            fprintf(stderr, "kernel_launch: unexpected shapes: n_in %d in0 %d out %d ws %zu (need %zu); nothing launched\n", n_in, n_in > 0 ? in_sizes[0] : -1, out_size, ws_size, (size_t)WS_END); grid = -1; return; }
        int dev = 0, cus = 0, per_cu = 0;
        if (hipGetDevice(&dev) != hipSuccess || hipDeviceGetAttribute(&cus, hipDeviceAttributeMultiprocessorCount, dev) != hipSuccess) { grid = -1; return; }
        if (hipFuncSetAttribute((const void*)mk_fwd, hipFuncAttributeMaxDynamicSharedMemorySize, LDS_BYTES) != hipSuccess) { fprintf(stderr, "kernel_launch: hipFuncSetAttribute failed\n"); grid = -1; return; }
        if (hipOccupancyMaxActiveBlocksPerMultiprocessor(&per_cu, (const void*)mk_fwd, 512, LDS_BYTES) != hipSuccess || per_cu < 1) { fprintf(stderr, "kernel_launch: occupancy query gives %d\n", per_cu); per_cu = 1; }
        (void)hipGetLastError();
        grid = cus;
        fprintf(stderr, "kernel_launch: cus %d per_cu %d grid %d ws %zu\n", cus, per_cu, grid, ws_size);
    }
    if (grid < 0) return;
    Args a{};
    for (int i = 0; i < 19; ++i) a.in[i] = d_in[i];
    a.out = (float*)d_out; a.ws = (unsigned char*)d_ws;
#if MK_SPLIT
    for (int p = 0; p < NPH; ++p) { a.ph_lo = p; a.ph_hi = p + 1; void* args[] = {&a};
        hipError_t e = hipLaunchCooperativeKernel((const void*)mk_fwd, dim3(grid), dim3(512), args, LDS_BYTES, stream);
        if (e != hipSuccess) { fprintf(stderr, "launch %d failed: %s\n", p, hipGetErrorString(e)); break; } }
#else
    a.ph_lo = 0; a.ph_hi = MK_LAST; void* args[] = {&a};
    hipError_t e = hipLaunchCooperativeKernel((const void*)mk_fwd, dim3(grid), dim3(512), args, LDS_BYTES, stream);
    if (e != hipSuccess) fprintf(stderr, "cooperative launch failed: %s (grid %d)\n", hipGetErrorString(e), grid);
#endif
}
```

```cpp
#include <hip/hip_runtime.h>
#include <hip/hip_cooperative_groups.h>
#include <cstdio>
#include <cstdint>
#ifndef MK_TS
#define MK_TS -1
#endif
namespace pg8 {
#define PG8_LAS __attribute__((address_space(3)))
typedef unsigned short bf16_t;
typedef short bf16x8 __attribute__((ext_vector_type(8)));
typedef float f32x4 __attribute__((ext_vector_type(4)));
typedef unsigned u32x4 __attribute__((ext_vector_type(4)));
constexpr int BM = 256, BK = 64, HALF = 128, HTB = HALF * BK * 2  , STAGE_BYTES = 8 * HTB, NXCD = 8, WGM = 4;

__host__ __device__ __forceinline__ int lds_byte(int r, int c) { const int st = (r >> 4) * 2 + (c >> 5), rr = r & 15, cc = c & 31, ob = rr * 64 + cc * 2; return st * 1024 + (ob ^ (((ob >> 9) & 1) << 5)); }
__host__ __device__ __forceinline__ void stage_rc(int b, int& R, int& C) { const int st = b / 1024, sb = b % 1024, swz = sb ^ (((sb >> 9) & 1) << 5); R = (st >> 1) * 16 + swz / 64; C = (st & 1) * 32 + (swz % 64) / 2; }
__host__ __device__ __forceinline__ int perm32(int rho) { const int n = rho >> 4, i = rho & 15; return 8 * (i >> 2) + 4 * n + (i & 3); }

struct Unit { int pm, pn; };
struct Gemm { const bf16_t* A; const bf16_t* Bt; int M, N, K, ld; };
constexpr int ACT_LD = 2816 + 64;

struct StaticOrder {
    int nM, nN, nwg, G, c;
    __host__ __device__ void init(int M, int N, int G_, int c_) { nM = M / BM; nN = N / BM; nwg = nM * nN; G = G_; c = c_; }
    __host__ __device__ bool next(int i, Unit& u) const {
        const long L = (long)i * G + c; if (L >= nwg) return false;
        int wgid = (int)L; { const int q = nwg / NXCD, r = nwg % NXCD, xcd = wgid % NXCD, off = wgid / NXCD; wgid = (xcd < r ? xcd * (q + 1) : r * (q + 1) + (xcd - r) * q) + off; }
        const int nig = WGM * nN, gid = wgid / nig, fm = gid * WGM, gsz = (nM - fm) < WGM ? (nM - fm) : WGM;
        u.pm = fm + ((wgid % nig) % gsz); u.pn = (wgid % nig) / gsz; return true;
    }
    __device__ __forceinline__ void a_ready(const Unit&) const {}
    __device__ __forceinline__ void done(const Unit&) const {}
};

typedef float f32x2 __attribute__((ext_vector_type(2)));
typedef __bf16 bf16x2_t __attribute__((ext_vector_type(2)));
__device__ __forceinline__ unsigned cvt_pk_bf16(float lo, float hi) { f32x2 v = {lo, hi}; bf16x2_t b = __builtin_convertvector(v, bf16x2_t); return __builtin_bit_cast(unsigned, b); }
typedef unsigned u32x2 __attribute__((ext_vector_type(2)));
__device__ __forceinline__ u32x2 pack4(f32x4 v) { u32x2 w; w.x = cvt_pk_bf16(v[0], v[1]); w.y = cvt_pk_bf16(v[2], v[3]); return w; }
__device__ __forceinline__ u32x4 pack8(f32x4 v0, f32x4 v1) { u32x4 w; w.x = cvt_pk_bf16(v0[0], v0[1]); w.y = cvt_pk_bf16(v0[2], v0[3]); w.z = cvt_pk_bf16(v1[0], v1[1]); w.w = cvt_pk_bf16(v1[2], v1[3]); return w; }
__device__ __forceinline__ float gelu_tanh(float x) {
    const float u = x * (1.0f + 0.044715f * x * x);
    const float e = __builtin_amdgcn_exp2f(u * (-2.0f * 0.7978845608028654f * 1.4426950408889634f));
    return x * __builtin_amdgcn_rcpf(1.0f + e);
}
__device__ __forceinline__ f32x2 gelu_tanh2(f32x2 x) {
    const f32x2 u = x * (x * x * 0.044715f + 1.0f);
    const f32x2 a = u * (-2.0f * 0.7978845608028654f * 1.4426950408889634f);
    f32x2 e; e.x = __builtin_amdgcn_exp2f(a.x); e.y = __builtin_amdgcn_exp2f(a.y);
    const f32x2 d = e + 1.0f; f32x2 r; r.x = __builtin_amdgcn_rcpf(d.x); r.y = __builtin_amdgcn_rcpf(d.y);
    return x * r;
}
__device__ __forceinline__ float silu_f(float x) { return x * __builtin_amdgcn_rcpf(1.0f + __builtin_amdgcn_exp2f(x * -1.4426950408889634f)); }
__device__ __forceinline__ float rs_of(const f32x4 p) { return __builtin_amdgcn_rsqf(((p[0] + p[1]) + (p[2] + p[3])) * (1.0f / 1024.0f) + 1e-6f); }
__device__ __forceinline__ float row_rs(const float* part, int row) { return rs_of(*(const f32x4*)(part + (size_t)row * 4)); }

constexpr int PF_PART = 131072 + 4096, PF_COEF = 131072 + 8192, PF_COS = 131072 + 8192;
__device__ __forceinline__ void prefetch_part(const float* part, int pm, int wid, PG8_LAS unsigned char* lds) {
    int z_; asm volatile("s_mov_b32 %0, 0" : "=s"(z_)); const int l_ = __builtin_amdgcn_mbcnt_hi(~0u, __builtin_amdgcn_mbcnt_lo(~0u, (unsigned)z_)); const int w4 = wid & 3;
    __builtin_amdgcn_global_load_lds((const unsigned*)(part + (size_t)(pm * BM + 64 * w4 + l_) * 4), (PG8_LAS unsigned*)(lds + PF_PART + w4 * 1024), 16, 0, 0);
}

struct EpiInProj {
    static constexpr bool PERM = true, AFTER_DRAIN = false; static constexpr bool PREF = true; static constexpr int NPF = 2;
    const float* part; const float* cs; const float* sn; bf16_t* R; float qscale; size_t seg_stride;
    PG8_LAS unsigned char* ldsb;
    __device__ __forceinline__ void prefetch(const Unit& u, int wid, PG8_LAS unsigned char* lds) const {
        int z_; asm volatile("s_mov_b32 %0, 0" : "=s"(z_)); const int l_ = __builtin_amdgcn_mbcnt_hi(~0u, __builtin_amdgcn_mbcnt_lo(~0u, (unsigned)z_));
#pragma unroll
        for (int i = 0; i < 2; ++i) { const int sl = 2 * wid + i, q = sl & 3, kind = sl >> 2;
            const float* tab = (kind == 1) ? cs : sn;
            const float* src = (kind == 0 || kind == 3) ? part + (size_t)(u.pm * BM + 64 * q + l_) * 4 : tab + (size_t)(u.pm * BM + 32 * q + (l_ >> 1)) * 8 + (l_ & 1) * 4;
            const int dst = (kind == 0 || kind == 3) ? PF_PART + q * 1024 : PF_COS + (kind - 1) * 4096 + q * 1024;
            __builtin_amdgcn_global_load_lds((const unsigned*)src, (PG8_LAS unsigned*)(lds + dst), 16, 0, 0); }
    }
    __device__ __forceinline__ void operator()(const f32x4 (&acc)[2][2][4][2], const Unit& u, int wr, int wc, int fr_in, int fq_in) const {
        int z_; asm volatile("s_mov_b32 %0, 0" : "=s"(z_)); const int l_ = __builtin_amdgcn_mbcnt_hi(~0u, __builtin_amdgcn_mbcnt_lo(~0u, (unsigned)z_)); const int fr = l_ & 15, fq = l_ >> 4; (void)fr_in; (void)fq_in;
        const int t = u.pn >> 1;
        bf16_t* O = R + (size_t)t * seg_stride;
        const int colt = (u.pn & 1) * 256 + wc * 32 + 8 * fq;
        const bool isrope = (t == 2 || t == 3);
        const bool roper = isrope && ((wc & 1) == 0) && (fq < 2);
        const float qs = (t == 2) ? qscale : 1.0f;
        const int row0 = u.pm * BM + wr * 64 + 4 * fr;
        f32x4 pr[2][4];
#pragma unroll
        for (int ai = 0; ai < 2; ++ai)
#pragma unroll
            for (int m = 0; m < 4; ++m) pr[ai][m] = *(const PG8_LAS f32x4*)(ldsb + PF_PART + (ai * HALF + wr * 64 + 4 * fr + m) * 16);
        float rsv[2][4];
#pragma unroll
        for (int ai = 0; ai < 2; ++ai)
#pragma unroll
            for (int m = 0; m < 4; ++m) rsv[ai][m] = rs_of(pr[ai][m]);
        asm volatile("" : "+v"(rsv[0][0]), "+v"(rsv[0][1]), "+v"(rsv[0][2]), "+v"(rsv[0][3]), "+v"(rsv[1][0]), "+v"(rsv[1][1]), "+v"(rsv[1][2]), "+v"(rsv[1][3]));
        if (t < 2) {
#pragma unroll
            for (int ai = 0; ai < 2; ++ai)
#pragma unroll
                for (int m = 0; m < 4; ++m) { const float rs = rsv[ai][m]; bf16_t* rowp = O + (size_t)(row0 + ai * HALF + m) * 512 + colt;
#pragma unroll
                    for (int bj = 0; bj < 2; ++bj) { f32x4 v0 = acc[ai][bj][m][0] * rs, v1 = acc[ai][bj][m][1] * rs;
#pragma unroll
                        for (int j = 0; j < 4; j += 2) { const f32x2 g0 = gelu_tanh2((f32x2){v0[j], v0[j + 1]}), g1 = gelu_tanh2((f32x2){v1[j], v1[j + 1]}); v0[j] = g0.x; v0[j + 1] = g0.y; v1[j] = g1.x; v1[j + 1] = g1.y; }
                        *(u32x4*)(rowp + bj * HALF) = pack8(v0, v1); } }
        } else if (isrope) {
            f32x4 cvv[4], svv[4];
#pragma unroll
            for (int m = 0; m < 4; ++m) { const size_t ro = (size_t)(row0 + HALF + m) * 8 + 4 * (fq & 1); cvv[m] = *(const f32x4*)(cs + ro); svv[m] = *(const f32x4*)(sn + ro); }
#pragma unroll
            for (int ai = 0; ai < 2; ++ai) {
#pragma unroll
                for (int m = 0; m < 4; ++m) { const float rs = rsv[ai][m] * qs; bf16_t* rowp = O + (size_t)(row0 + ai * HALF + m) * 512 + colt;
                    f32x4 cv, sv;
                    if (ai == 0) { const PG8_LAS unsigned char* cp_ = ldsb + PF_COS + (wr * 64 + 4 * fr + m) * 32 + (fq & 1) * 16; cv = *(const PG8_LAS f32x4*)cp_; sv = *(const PG8_LAS f32x4*)(cp_ + 4096); }
                    else { cv = cvv[m]; sv = svv[m]; asm volatile("" : "+v"(cv), "+v"(sv)); }
#pragma unroll
                    for (int bj = 0; bj < 2; ++bj) { f32x4 v0 = acc[ai][bj][m][0] * rs, v1 = acc[ai][bj][m][1] * rs;
                        if (roper) {
                            const float a0 = v0[0], b0 = v0[1], a1 = v0[2], b1 = v0[3], a2 = v1[0], b2 = v1[1], a3 = v1[2], b3 = v1[3];
                            v0[0] = a0 * cv[0] - b0 * sv[0]; v0[1] = b0 * cv[0] + a0 * sv[0];
                            v0[2] = a1 * cv[1] - b1 * sv[1]; v0[3] = b1 * cv[1] + a1 * sv[1];
                            v1[0] = a2 * cv[2] - b2 * sv[2]; v1[1] = b2 * cv[2] + a2 * sv[2];
                            v1[2] = a3 * cv[3] - b3 * sv[3]; v1[3] = b3 * cv[3] + a3 * sv[3];
                        }
                        *(u32x4*)(rowp + bj * HALF) = pack8(v0, v1); } }
                asm volatile("" ::: "memory");
            }
        } else {
#pragma unroll
            for (int ai = 0; ai < 2; ++ai)
#pragma unroll
                for (int m = 0; m < 4; ++m) { const float rs = rsv[ai][m]; bf16_t* rowp = O + (size_t)(row0 + ai * HALF + m) * 512 + colt;
#pragma unroll
                    for (int bj = 0; bj < 2; ++bj) *(u32x4*)(rowp + bj * HALF) = pack8(acc[ai][bj][m][0] * rs, acc[ai][bj][m][1] * rs); }
        }
    }
};

struct EpiResid {
    static constexpr bool PERM = true, AFTER_DRAIN = false; static constexpr bool PREF = false; static constexpr int NPF = 0;
    bf16_t* H; float* part; PG8_LAS float* xch;
    __device__ __forceinline__ void operator()(const f32x4 (&acc)[2][2][4][2], const Unit& u, int wr, int wc, int fr_in, int fq_in) const {
        int z_; asm volatile("s_mov_b32 %0, 0" : "=s"(z_)); const int l_ = __builtin_amdgcn_mbcnt_hi(~0u, __builtin_amdgcn_mbcnt_lo(~0u, (unsigned)z_)); const int fr = l_ & 15, fq = l_ >> 4; (void)fr_in; (void)fq_in;
        const int col0 = u.pn * BM + wc * 32 + 8 * fq;
        u32x4 raw[2][4][2];
#pragma unroll
        for (int ai = 0; ai < 2; ++ai)
#pragma unroll
            for (int m = 0; m < 4; ++m) { const bf16_t* hp = H + (size_t)(u.pm * BM + ai * HALF + wr * 64 + 4 * fr + m) * 1024 + col0;
                raw[ai][m][0] = *(const u32x4*)hp; raw[ai][m][1] = *(const u32x4*)(hp + HALF); }
        asm volatile("" ::: "memory");
#pragma unroll
        for (int ai = 0; ai < 2; ++ai)
#pragma unroll
            for (int m = 0; m < 4; ++m) {
                const int row = u.pm * BM + ai * HALF + wr * 64 + 4 * fr + m;
                bf16_t* hp = H + (size_t)row * 1024 + col0;
                float ss = 0.f;
#pragma unroll
                for (int bj = 0; bj < 2; ++bj) {
                    const u32x4 rw = raw[ai][m][bj];
                    f32x4 h0, h1;
                    h0[0] = __uint_as_float(rw.x << 16); h0[1] = __uint_as_float(rw.x & 0xffff0000u); h0[2] = __uint_as_float(rw.y << 16); h0[3] = __uint_as_float(rw.y & 0xffff0000u);
                    h1[0] = __uint_as_float(rw.z << 16); h1[1] = __uint_as_float(rw.z & 0xffff0000u); h1[2] = __uint_as_float(rw.w << 16); h1[3] = __uint_as_float(rw.w & 0xffff0000u);
                    h0 = h0 + acc[ai][bj][m][0]; h1 = h1 + acc[ai][bj][m][1];
                    ss += ((h0[0] * h0[0] + h0[1] * h0[1]) + (h0[2] * h0[2] + h0[3] * h0[3])) + ((h1[0] * h1[0] + h1[1] * h1[1]) + (h1[2] * h1[2] + h1[3] * h1[3]));
                    *(u32x4*)(hp + bj * HALF) = pack8(h0, h1);
                }
                ss += __int_as_float(__builtin_amdgcn_ds_bpermute(4 * ((fq * 16 + fr) ^ 16), __float_as_int(ss))); ss += __int_as_float(__builtin_amdgcn_ds_bpermute(4 * ((fq * 16 + fr) ^ 32), __float_as_int(ss)));
                if (fq == 0) xch[(wr * 4 + wc) * 128 + ai * 64 + 4 * fr + m] = ss;
            }
        asm volatile("s_waitcnt lgkmcnt(0)\n\ts_barrier" ::: "memory");
        if (wc == 0) {
#pragma unroll
            for (int k = 0; k < 2; ++k) { const int r = l_ + 64 * k;
                const float s = (xch[(wr * 4 + 0) * 128 + r] + xch[(wr * 4 + 1) * 128 + r]) + (xch[(wr * 4 + 2) * 128 + r] + xch[(wr * 4 + 3) * 128 + r]);
                const int row = u.pm * BM + (r >> 6) * HALF + wr * 64 + (r & 63);
                part[(size_t)row * 4 + u.pn] = s; }
        }
        asm volatile("s_waitcnt lgkmcnt(0)\n\ts_barrier" ::: "memory");
    }
};

struct EpiUp {
    static constexpr bool PERM = true, AFTER_DRAIN = false; static constexpr bool PREF = true; static constexpr int NPF = 1;
    const float* part; const float* cw; const float* cb; bf16_t* act; bf16_t* top; bf16_t* bot;
    PG8_LAS unsigned char* ldsb;
    __device__ __forceinline__ void prefetch(const Unit& u, int wid, PG8_LAS unsigned char* lds) const {
        if (wid < 4) { prefetch_part(part, u.pm, wid, lds); return; }
        int z_; asm volatile("s_mov_b32 %0, 0" : "=s"(z_)); const int l_ = __builtin_amdgcn_mbcnt_hi(~0u, __builtin_amdgcn_mbcnt_lo(~0u, (unsigned)z_)); const int j = wid - 4;
        const float* src = (j < 3 ? cw + (size_t)j * 5632 : cb) + (l_ >> 5) * 2816 + u.pn * 128 + (l_ & 31) * 4;
        __builtin_amdgcn_global_load_lds((const unsigned*)src, (PG8_LAS unsigned*)(lds + PF_COEF + j * 1024), 16, 0, 0);
    }
    __device__ __forceinline__ void operator()(f32x4 (&acc)[2][2][4][2], const Unit& u, int wr, int wc, int fr_in, int fq_in) const {
        int z_; asm volatile("s_mov_b32 %0, 0" : "=s"(z_)); const int l_ = __builtin_amdgcn_mbcnt_hi(~0u, __builtin_amdgcn_mbcnt_lo(~0u, (unsigned)z_)); const int fr = l_ & 15, fq = l_ >> 4; (void)fr_in; (void)fq_in;
        const int cbase = u.pn * 128 + wc * 32 + 8 * fq;
        f32x4 kg[2][4], kv[2][4];
#define UP_COEF(n) do { const PG8_LAS unsigned char* cp_ = ldsb + PF_COEF + (wc * 32 + 8 * fq + 4 * (n)) * 4;     \
        _Pragma("unroll") for (int j_ = 0; j_ < 4; ++j_) { kg[n][j_] = *(const PG8_LAS f32x4*)(cp_ + j_ * 1024); kv[n][j_] = *(const PG8_LAS f32x4*)(cp_ + j_ * 1024 + 512); } } while (0)
        {
            const PG8_LAS f32x4* pp = (const PG8_LAS f32x4*)(ldsb + PF_PART + (wr * 64 + 4 * fr) * 16);
            f32x4 pr[2][4];
#pragma unroll
            for (int ai = 0; ai < 2; ++ai)
#pragma unroll
                for (int m = 0; m < 4; ++m) pr[ai][m] = pp[(size_t)(ai * HALF + m)];
            UP_COEF(0);
#pragma unroll
            for (int ai = 0; ai < 2; ++ai)
#pragma unroll
                for (int m = 0; m < 4; ++m) { const float rs = rs_of(pr[ai][m]);
#pragma unroll
                    for (int bj = 0; bj < 2; ++bj)
#pragma unroll
                        for (int n = 0; n < 2; ++n) acc[ai][bj][m][n] = acc[ai][bj][m][n] * rs; }
        }
        asm volatile("" ::: "memory");
        UP_COEF(1);
#undef UP_COEF
        asm volatile("" ::: "memory");
        { int z2_; asm volatile("s_mov_b32 %0, 0" : "=s"(z2_)); const int l2_ = __builtin_amdgcn_mbcnt_hi(~0u, __builtin_amdgcn_mbcnt_lo(~0u, (unsigned)z2_)); const int fr = l2_ & 15, cbase = u.pn * 128 + wc * 32 + 8 * (l2_ >> 4);
#pragma unroll
        for (int ai = 0; ai < 2; ++ai) { const int blk = (u.pm * BM + ai * HALF + wr * 64) >> 6;
#pragma unroll
            for (int n = 0; n < 2; ++n) { const int ch = cbase + 4 * n;
                if (fr == 0) { bf16_t* tp = top + (size_t)(blk * 2) * 5632 + ch; *(u32x2*)tp = pack4(acc[ai][0][0][n]); *(u32x2*)(tp + 2816) = pack4(acc[ai][1][0][n]); *(u32x2*)(tp + 5632) = pack4(acc[ai][0][1][n]); *(u32x2*)(tp + 5632 + 2816) = pack4(acc[ai][1][1][n]); }
                if (fr == 15) { bf16_t* bp = bot + (size_t)(blk * 2) * 5632 + ch; *(u32x2*)bp = pack4(acc[ai][0][2][n]); *(u32x2*)(bp + 2816) = pack4(acc[ai][1][2][n]); *(u32x2*)(bp + 5632) = pack4(acc[ai][0][3][n]); *(u32x2*)(bp + 5632 + 2816) = pack4(acc[ai][1][3][n]); } } } }
#define UP_SHR0(srcv) __int_as_float(__builtin_amdgcn_update_dpp(0, __float_as_int(srcv), 0x111, 0xf, 0xf, true))
        {
#pragma unroll
            for (int n = 0; n < 2; ++n)
#pragma unroll
                for (int jp = 0; jp < 2; ++jp) {
                    const int j0 = 2 * jp, j1 = 2 * jp + 1;
                    const f32x2 G0 = {kg[n][0][j0], kg[n][0][j1]}, G1 = {kg[n][1][j0], kg[n][1][j1]}, G2 = {kg[n][2][j0], kg[n][2][j1]}, GB = {kg[n][3][j0], kg[n][3][j1]};
                    const f32x2 V0 = {kv[n][0][j0], kv[n][0][j1]}, V1 = {kv[n][1][j0], kv[n][1][j1]}, V2 = {kv[n][2][j0], kv[n][2][j1]}, VB = {kv[n][3][j0], kv[n][3][j1]};
#pragma unroll
                    for (int ai = 0; ai < 2; ++ai) {
                        f32x2 xg[4], xv[4];
#pragma unroll
                        for (int m = 0; m < 4; ++m) { xg[m] = (f32x2){acc[ai][0][m][n][j0], acc[ai][0][m][n][j1]}; xv[m] = (f32x2){acc[ai][1][m][n][j0], acc[ai][1][m][n][j1]}; }
                        f32x2 dg3, dg2, dv3, dv2;
                        dg3.x = UP_SHR0(xg[3].x); dg3.y = UP_SHR0(xg[3].y); dg2.x = UP_SHR0(xg[2].x); dg2.y = UP_SHR0(xg[2].y);
                        dv3.x = UP_SHR0(xv[3].x); dv3.y = UP_SHR0(xv[3].y); dv2.x = UP_SHR0(xv[2].x); dv2.y = UP_SHR0(xv[2].y);
#pragma unroll
                        for (int m = 3; m >= 0; --m) {
                            const f32x2 g1 = m >= 1 ? xg[m >= 1 ? m - 1 : 0] : dg3, g2 = m >= 2 ? xg[m >= 2 ? m - 2 : 0] : (m == 1 ? dg3 : dg2);
                            const f32x2 v1 = m >= 1 ? xv[m >= 1 ? m - 1 : 0] : dv3, v2 = m >= 2 ? xv[m >= 2 ? m - 2 : 0] : (m == 1 ? dv3 : dv2);
                            const f32x2 cg = GB + G2 * xg[m] + G1 * g1 + G0 * g2;
                            const f32x2 cv = VB + V2 * xv[m] + V1 * v1 + V0 * v2;
                            const f32x2 ea = cg * -1.4426950408889634f; f32x2 ee; ee.x = __builtin_amdgcn_exp2f(ea.x); ee.y = __builtin_amdgcn_exp2f(ea.y);
                            const f32x2 dd = ee + 1.0f; f32x2 rr; rr.x = __builtin_amdgcn_rcpf(dd.x); rr.y = __builtin_amdgcn_rcpf(dd.y);
                            const f32x2 oo = (cg * rr) * cv; float o0 = oo.x, o1 = oo.y;
                            asm volatile("" : "+v"(o0), "+v"(o1));
                            acc[ai][0][m][n][j0] = o0; acc[ai][0][m][n][j1] = o1;
                        }
                    }
                }
        }
#undef UP_SHR0
        asm volatile("" ::: "memory");
        { int z4_; asm volatile("s_mov_b32 %0, 0" : "=s"(z4_)); const int l4_ = __builtin_amdgcn_mbcnt_hi(~0u, __builtin_amdgcn_mbcnt_lo(~0u, (unsigned)z4_)); const int fr = l4_ & 15, cbase = u.pn * 128 + wc * 32 + 8 * (l4_ >> 4);
#pragma unroll
        for (int ai = 0; ai < 2; ++ai)
#pragma unroll
            for (int m = 0; m < 4; ++m) { const int row = u.pm * BM + ai * HALF + wr * 64 + 4 * fr + m;
                if (!(m < 2 && fr == 0)) *(u32x4*)(act + (size_t)row * ACT_LD + cbase) = pack8(acc[ai][0][m][0], acc[ai][0][m][1]); } }
    }
};

template <class Epi, class Sched, bool ALIGN_EPI = false, bool SP2 = false, bool VW = false>
__device__ __forceinline__ void gemm_phase(PG8_LAS unsigned char* lds, const Gemm g, const Sched& S, const Epi& E, const int tid) {
    const int wid = __builtin_amdgcn_readfirstlane(tid >> 6), lane = tid & 63, wr = wid >> 2, wc = wid & 3, fr = lane & 15, fq = lane >> 4;
    const int K = g.ld, nt = g.K / BK;
    unsigned voffA[2], voffB[2];
#pragma unroll
    for (int i = 0; i < 2; ++i) { int R, C; stage_rc(tid * 16 + i * 8192, R, C); const int Rb = Epi::PERM ? ((R & ~31) + perm32(R & 31)) : R;
        const int Ra = (R & ~63) + 4 * (R & 15) + ((R >> 4) & 3);
        voffA[i] = (unsigned)(Ra * K + C) * 2u; voffB[i] = (unsigned)(Rb * K + C) * 2u; }
    const size_t kstep = (size_t)(BK * 2);
    const size_t hstep = (size_t)HALF * K * 2;
    const size_t tstep = 2 * hstep;
    const unsigned ldsw = (unsigned)wid * 1024u;
    const int aoff = lds_byte(wr * 64 + fr, fq * 8), boff = lds_byte(wc * 32 + fr, fq * 8);
#define PG8_SA(b, h) (((b) * 2 + (h)) * HTB)
#define PG8_SB(b, h) ((4 + (b) * 2 + (h)) * HTB)
#define PG8_STAGE(bufoff, gbase, voff) do { _Pragma("unroll") for (int _i = 0; _i < 2; ++_i) \
        __builtin_amdgcn_global_load_lds((const unsigned*)((const char*)(gbase) + (voff)[_i]), (PG8_LAS unsigned*)(lds + (bufoff) + ldsw + _i * 8192), 16, 0, 0); } while (0)
#define PG8_LDA(dst, b, h) do { _Pragma("unroll") for (int m = 0; m < 4; ++m) _Pragma("unroll") for (int k = 0; k < 2; ++k) dst[m][k] = *(const PG8_LAS bf16x8*)(lds + PG8_SA(b, h) + aoff + m * 2048 + k * 1024); } while (0)
#define PG8_LDB(dst, b, h) do { _Pragma("unroll") for (int n = 0; n < 2; ++n) _Pragma("unroll") for (int k = 0; k < 2; ++k) dst[n][k] = *(const PG8_LAS bf16x8*)(lds + PG8_SB(b, h) + boff + n * 2048 + k * 1024); } while (0)
#define PG8_MMA(ai, bj, At, Bt) do { __builtin_amdgcn_s_setprio(1); _Pragma("unroll") for (int m = 0; m < 4; ++m) _Pragma("unroll") for (int n = 0; n < 2; ++n) _Pragma("unroll") for (int k = 0; k < 2; ++k) \
        acc[ai][bj][m][n] = __builtin_amdgcn_mfma_f32_16x16x32_bf16(Bt[n][k], At[m][k], acc[ai][bj][m][n], 0, 0, 0); __builtin_amdgcn_s_setprio(0); } while (0)
#define PG8_WAIT_V(n) asm volatile("s_waitcnt vmcnt(" #n ")" ::: "memory")
#define PG8_WAIT_L(n) asm volatile("s_waitcnt lgkmcnt(" #n ")" ::: "memory")
#define PG8_BAR __builtin_amdgcn_s_barrier()
#define PG8_SCHED __builtin_amdgcn_sched_barrier(0)
    if constexpr (VW) __builtin_amdgcn_s_waitcnt(0x0F70);
    Unit cur, nxt; int ui = 0;
    if (!S.next(0, cur)) return;
    f32x4 acc[2][2][4][2];
#pragma unroll
    for (int a = 0; a < 2; ++a)
#pragma unroll
        for (int b = 0; b < 2; ++b)
#pragma unroll
            for (int m = 0; m < 4; ++m)
#pragma unroll
                for (int n = 0; n < 2; ++n) acc[a][b][m][n] = (f32x4){0.f, 0.f, 0.f, 0.f};
    bf16x8 At[4][2], B0[2][2], B1[2][2];
    const char* cA = (const char*)g.A + (size_t)cur.pm * tstep; const char* cB = (const char*)g.Bt + (size_t)cur.pn * tstep;
    S.a_ready(cur);
    if constexpr (SP2) {
        PG8_STAGE(PG8_SB(0, 0), cB, voffB); PG8_STAGE(PG8_SB(0, 1), cB + hstep, voffB); PG8_STAGE(PG8_SA(0, 0), cA, voffA); PG8_STAGE(PG8_SA(0, 1), cA + hstep, voffA);
        if (wr == 1) PG8_BAR;
        PG8_WAIT_V(2); PG8_BAR;
        PG8_STAGE(PG8_SB(1, 0), cB + kstep, voffB); PG8_STAGE(PG8_SA(1, 0), cA + kstep, voffA); PG8_STAGE(PG8_SB(1, 1), cB + hstep + kstep, voffB);
        PG8_WAIT_V(6); PG8_BAR;
    } else {
        PG8_STAGE(PG8_SB(0, 0), cB, voffB); PG8_STAGE(PG8_SA(0, 0), cA, voffA); PG8_STAGE(PG8_SB(0, 1), cB + hstep, voffB); PG8_STAGE(PG8_SA(0, 1), cA + hstep, voffA);
        if (wr == 1) PG8_BAR;
        PG8_WAIT_V(4); PG8_BAR;
        PG8_STAGE(PG8_SB(1, 0), cB + kstep, voffB); PG8_STAGE(PG8_SA(1, 0), cA + kstep, voffA); PG8_STAGE(PG8_SB(1, 1), cB + hstep + kstep, voffB);
        PG8_WAIT_V(6); PG8_BAR;
    }
    for (;;) {
        const bool has_next = S.next(ui + 1, nxt);
        const char* nA = has_next ? (const char*)g.A + (size_t)nxt.pm * tstep : cA; const char* nB = has_next ? (const char*)g.Bt + (size_t)nxt.pn * tstep : cB;
        for (int t = 0; t < nt; t += 2) {
            const bool last = (t == nt - 2);
            const char* a1 = cA + (size_t)(t + 1) * kstep;
            const char* a2 = last ? nA : cA + (size_t)(t + 2) * kstep; const char* b2 = last ? nB : cB + (size_t)(t + 2) * kstep;
            const char* a3 = a2 + kstep; const char* b3 = b2 + kstep;
            if (last && has_next) S.a_ready(nxt);
            if constexpr (SP2) {
            if constexpr (Epi::PREF) { if (last) E.prefetch(cur, wid, lds); }
            PG8_LDB(B0, 0, 0); PG8_LDB(B1, 0, 1); PG8_SCHED; PG8_LDA(At, 0, 0); PG8_STAGE(PG8_SA(1, 1), a1 + hstep, voffA);
            if (Epi::PREF && last) { if constexpr (Epi::NPF == 2) PG8_WAIT_V(10); else PG8_WAIT_V(9); } else PG8_WAIT_V(8); PG8_WAIT_L(0); PG8_BAR; PG8_MMA(0, 0, At, B0); PG8_MMA(0, 1, At, B1); PG8_BAR; PG8_SCHED;
            PG8_LDA(At, 0, 1); PG8_STAGE(PG8_SB(0, 0), b2, voffB); PG8_STAGE(PG8_SB(0, 1), b2 + hstep, voffB); PG8_STAGE(PG8_SA(0, 0), a2, voffA);
            if (Epi::PREF && last) { if constexpr (Epi::NPF == 2) PG8_WAIT_V(10); else PG8_WAIT_V(9); } else PG8_WAIT_V(8); PG8_WAIT_L(0); PG8_BAR; PG8_MMA(1, 0, At, B0); PG8_MMA(1, 1, At, B1); PG8_BAR; PG8_SCHED;
            PG8_LDB(B0, 1, 0); PG8_LDB(B1, 1, 1); PG8_SCHED; PG8_LDA(At, 1, 0); PG8_STAGE(PG8_SA(0, 1), a2 + hstep, voffA);
            PG8_WAIT_V(8); PG8_WAIT_L(0); PG8_BAR; PG8_MMA(0, 0, At, B0); PG8_MMA(0, 1, At, B1); PG8_BAR; PG8_SCHED;
            PG8_LDA(At, 1, 1); PG8_STAGE(PG8_SB(1, 0), b3, voffB); PG8_STAGE(PG8_SB(1, 1), b3 + hstep, voffB); PG8_STAGE(PG8_SA(1, 0), a3, voffA);
            PG8_WAIT_V(8); PG8_WAIT_L(0); PG8_BAR; PG8_MMA(1, 0, At, B0); PG8_MMA(1, 1, At, B1); PG8_BAR; PG8_SCHED;
            } else {
            PG8_LDB(B0, 0, 0); PG8_SCHED; PG8_LDA(At, 0, 0); PG8_STAGE(PG8_SA(1, 1), a1 + hstep, voffA);
            PG8_WAIT_L(8); PG8_BAR; PG8_WAIT_L(0); PG8_MMA(0, 0, At, B0); PG8_BAR; PG8_SCHED;
            PG8_LDB(B1, 0, 1); PG8_STAGE(PG8_SB(0, 0), b2, voffB);
            PG8_BAR; PG8_WAIT_L(0); PG8_MMA(0, 1, At, B1); PG8_BAR;
            PG8_LDA(At, 0, 1); PG8_STAGE(PG8_SA(0, 0), a2, voffA);
            PG8_BAR; PG8_WAIT_L(0); PG8_MMA(1, 0, At, B0); PG8_BAR; PG8_SCHED;
            PG8_STAGE(PG8_SB(0, 1), b2 + hstep, voffB);
            PG8_WAIT_V(6); PG8_BAR; PG8_MMA(1, 1, At, B1); PG8_BAR;
            PG8_LDB(B0, 1, 0); PG8_SCHED; PG8_LDA(At, 1, 0); PG8_STAGE(PG8_SA(0, 1), a2 + hstep, voffA);
            PG8_WAIT_L(8); PG8_BAR; PG8_WAIT_L(0); PG8_MMA(0, 0, At, B0); PG8_BAR; PG8_SCHED;
            PG8_LDB(B1, 1, 1); PG8_STAGE(PG8_SB(1, 0), b3, voffB);
            PG8_BAR; PG8_WAIT_L(0); PG8_MMA(0, 1, At, B1); PG8_BAR;
            PG8_LDA(At, 1, 1); PG8_STAGE(PG8_SA(1, 0), a3, voffA);
            PG8_BAR; PG8_WAIT_L(0); PG8_MMA(1, 0, At, B0); PG8_BAR; PG8_SCHED;
            PG8_STAGE(PG8_SB(1, 1), b3 + hstep, voffB);
            PG8_WAIT_V(6); PG8_BAR; PG8_MMA(1, 1, At, B1); PG8_BAR;
            }
        }
        if constexpr (ALIGN_EPI) { if (wr == 0) PG8_BAR; }
        if constexpr (!Epi::AFTER_DRAIN) { E(acc, cur, wr, wc, fr, fq); S.done(cur); }
        if (!has_next) break;
#pragma unroll
        for (int a = 0; a < 2; ++a)
#pragma unroll
            for (int b = 0; b < 2; ++b)
#pragma unroll
                for (int m = 0; m < 4; ++m)
#pragma unroll
                    for (int n = 0; n < 2; ++n) acc[a][b][m][n] = (f32x4){0.f, 0.f, 0.f, 0.f};
        cur = nxt; cA = nA; cB = nB; ++ui;
        if constexpr (ALIGN_EPI) { if (wr == 1) PG8_BAR; }
    }
    PG8_WAIT_V(0);
    if constexpr (!ALIGN_EPI) { if (wr == 0) PG8_BAR; }
    PG8_BAR;
    if constexpr (Epi::AFTER_DRAIN) { E.fused(acc, cur, wr, wc, fr, fq, lds, wid, lane); S.done(cur); }
#undef PG8_SA
#undef PG8_SB
#undef PG8_STAGE
#undef PG8_LDA
#undef PG8_LDB
#undef PG8_MMA
#undef PG8_WAIT_V
#undef PG8_WAIT_L
#undef PG8_BAR
#undef PG8_SCHED
}
}
#include <hip/hip_bf16.h>
#include <cmath>
namespace attn_body {
#if defined(MK_TS) && MK_TS == 20
#define APB0() apt0_ = __builtin_readcyclecounter()
#define APB1() apw_ += __builtin_readcyclecounter() - apt0_
#define APW(N) asm volatile("s_waitcnt vmcnt(" #N ") lgkmcnt(0)":::"memory")
#define ATTN_PROBE_OUT() do{ if(blockIdx.x==0&&tid==0){ A.park[16384*256+0]+=0; ((unsigned long long*)(A.park+16384*256))[mp+2*(qb&1)]=apw_; } }while(0)
#else
#define ATTN_PROBE_OUT() do{}while(0)
#define APB0() do{}while(0)
#define APW(N) do{}while(0)
#define APB1() do{}while(0)
#endif
using bf16=__hip_bfloat16;
using bf16x8=__attribute__((ext_vector_type(8)))short;
using s16x4=__attribute__((ext_vector_type(4)))short;
using f32x16=__attribute__((ext_vector_type(16)))float;
using u32x4=__attribute__((ext_vector_type(4)))unsigned;
constexpr int SEQ=4096,PQ=512,PM=1024;
constexpr int NW=8,QBLK=32,QB=QBLK*NW,KVBLK=64;
__device__ __forceinline__ int crow(int r,int hi){return (r&3)+8*(r>>2)+4*hi;}
#define SBAR() __builtin_amdgcn_sched_barrier(0)
__device__ __forceinline__ void cmask(f32x16&p0,f32x16&p1,int jb,int qrel,int hi){
  asm volatile("":"+v"(hi));
  const float NEG=-INFINITY; int kb=64*jb+4*hi;
  #pragma unroll
  for(int r=0;r<16;++r){int kv=kb+(r&3)+8*(r>>2); if(kv>qrel)p0[r]=NEG; if(kv+32>qrel)p1[r]=NEG;}
}
constexpr int KSLOT=8192,NKS=4,VSLOT=16384,NVS=3;
constexpr int LDS_K=0, LDS_V=NKS*KSLOT, LDS_WS=LDS_V+NVS*VSLOT, LDS_Q=LDS_WS+NW*64*4, LDS_BYTES=LDS_Q+NW*4096;
__device__ __forceinline__ void glds16(const void*sbase,unsigned voff,unsigned lds_dst){unsigned keep;
  asm volatile("s_mov_b32 %0, m0\n\ts_mov_b32 m0, %3\n\ts_nop 3\n\tglobal_load_lds_dwordx4 %1, %2\n\ts_mov_b32 m0, %0":"=&s"(keep):"v"(voff),"s"(sbase),"s"(lds_dst):"memory");}
typedef float f32x2_t __attribute__((ext_vector_type(2))); typedef __bf16 bf16x2_t __attribute__((ext_vector_type(2)));
__device__ __forceinline__ unsigned cvtpk_s(float lo,float hi){f32x2_t v={lo,hi};bf16x2_t b=__builtin_convertvector(v,bf16x2_t);return __builtin_bit_cast(unsigned,b);}
#define WAIT_BAR(N) asm volatile("s_waitcnt vmcnt(" #N ") lgkmcnt(0)\n\ts_barrier":::"memory")
typedef __attribute__((address_space(3))) const char* lds_cptr;
typedef short v4i16_t __attribute__((ext_vector_type(4)));
__device__ __forceinline__ bf16x8 kld(lds_cptr kp,int i){ return *(const __attribute__((address_space(3))) bf16x8*)(kp+(i>>1)*2048+(i&1)*512); }
__device__ __forceinline__ s16x4 vtr(lds_cptr p){ return __builtin_bit_cast(s16x4,__builtin_amdgcn_ds_read_tr16_b64_v4i16((__attribute__((address_space(3))) v4i16_t*)p)); }
#define MX3(a,b,c) __builtin_fmaxf(__builtin_fmaxf((a),(b)),(c))
__device__ __forceinline__ float rowmax(const f32x16&p0,const f32x16&p1){
  float a=MX3(p0[0],p0[1],p1[0]),b=MX3(p0[2],p0[3],p1[1]);a=MX3(a,p1[2],p1[3]);
  #pragma unroll
  for(int r=4;r<16;r+=4){a=MX3(a,p0[r],p0[r+1]);b=MX3(b,p0[r+2],p0[r+3]);a=MX3(a,p1[r],p1[r+1]);b=MX3(b,p1[r+2],p1[r+3]);}
  float m=__builtin_fmaxf(a,b);
  auto rr=__builtin_amdgcn_permlane32_swap(__float_as_uint(m),__float_as_uint(m),false,false);
  return __builtin_fmaxf(__uint_as_float(rr[0]),__uint_as_float(rr[1]));
}
#define MFMA32(a,b,c) __builtin_amdgcn_mfma_f32_32x32x16_bf16(a,b,c,0,0,0)
__device__ __forceinline__ int fresh_lane(){ int z_; asm volatile("s_mov_b32 %0, 0":"=s"(z_)); return __builtin_amdgcn_mbcnt_hi(~0u,__builtin_amdgcn_mbcnt_lo(~0u,(unsigned)z_)); }
#define QL(d0) (*(const __attribute__((address_space(3))) bf16x8*)(qp0+(d0)*1024))
struct AttnArgs { const bf16* Q; const bf16* K; const bf16* V; bf16* MIX; const float* subln; unsigned* park; float lam; float post; };

template<int THRL> __device__ __forceinline__ void attn_unit(const int tid,const int b,const int h,const int qb,const AttnArgs&A,char*shm){
  const int lane=tid&63,r32=lane&31,hi=lane>>5; const int wid=__builtin_amdgcn_readfirstlane(tid>>6);
  const long rowbase=(long)b*SEQ; const int q0=qb*QB;
  const unsigned lds0=(unsigned)(uintptr_t)shm;
  const unsigned koff=(unsigned)(lane*PQ+wid*8)*2u;
  const unsigned voff=(unsigned)((16*(wid&3)+(lane>>2))*PQ+(wid>>2)*32+(lane&3)*8)*2u;
  const unsigned kdst=lds0+LDS_K+wid*1024, vdst=lds0+LDS_V+wid*1024;
  const lds_cptr shm3=(lds_cptr)shm; const lds_cptr kp0=shm3+LDS_K+hi*1024+r32*16; const lds_cptr vp0=shm3+LDS_V+((lane>>4)&1)*32+(lane&3)*8+(4*hi+((lane&15)>>2))*64;
  const int NT=(q0+QB)/KVBLK;
  unsigned long long apw_=0,apt0_=0; (void)apw_; (void)apt0_;
  const lds_cptr qp0=shm3+LDS_Q+wid*4096+lane*16;
  const bf16*kptr=A.K+rowbase*PQ+(h*2)*64,*vptr=A.V+rowbase*PQ+h*128;
  for(int mp=0;mp<2;++mp){
  const bf16*Qw=A.Q+(rowbase+q0+wid*QBLK)*PQ+(h*2+mp)*64;
  #define DMA_K(t,slot) do{ glds16(kptr,koff,(unsigned)__builtin_amdgcn_readfirstlane(kdst+(slot))); kptr+=KVBLK*PQ; }while(0)
  #define DMA_V(t,slot) do{ glds16(vptr,voff,(unsigned)__builtin_amdgcn_readfirstlane(vdst+(slot))); glds16(vptr,voff+128u,(unsigned)__builtin_amdgcn_readfirstlane(vdst+(slot)+8192)); vptr+=KVBLK*PQ; }while(0)
  if(mp==0){ DMA_K(0,0);DMA_V(0,0);DMA_K(1,KSLOT); }
  bf16x8 qr[4];
  { int lq_=lane; asm volatile("":"+v"(lq_)); const unsigned qoff_=(unsigned)((lq_&31)*PQ+(lq_>>5)*8);
  _Pragma("unroll") for(int d0=0;d0<4;++d0)qr[d0]=*reinterpret_cast<const bf16x8*>(Qw+qoff_+d0*16); }
  _Pragma("unroll") for(int d0=0;d0<4;++d0)*(__attribute__((address_space(3))) bf16x8*)(const_cast<__attribute__((address_space(3))) char*>(qp0)+d0*1024)=qr[d0];
  float mhat=0.f,l_reg=0.f;f32x16 o[4];o[0]=f32x16{};o[1]=f32x16{};o[2]=f32x16{};o[3]=f32x16{};
  const f32x16 zero16=f32x16{};
  #define CMASK(P0,P1,t) do{int jb_=(t)-(NT-4); if(jb_>=0){ const int lf_=fresh_lane(); cmask(P0,P1,jb_,wid*QBLK+(lf_&31),lf_>>5); } }while(0)
  bool resc=false;
  #define RESC() do{ if(resc){ asm volatile("s_waitcnt lgkmcnt(0)":::"memory"); \
      const int hf_=fresh_lane()>>5; const float*wf_=(const float*)(shm+LDS_WS)+wid*64; _Pragma("unroll") for(int d_=0;d_<4;++d_) _Pragma("unroll") for(int r=0;r<16;++r)o[d_][r]*=wf_[crow(r,hf_)]; } }while(0)
  f32x16 pA0,pA1,pB0,pB1; bf16x8 kf[8];
  int ks_cur=0,ks_next=KSLOT;
  int vs_prev=0,vs_cur=0,vs_next=VSLOT;
  #define ROT() do{ ks_cur=ks_next; ks_next=(ks_next==(NKS-1)*KSLOT)?0:ks_next+KSLOT; vs_prev=vs_cur; vs_cur=vs_next; vs_next=(vs_next==(NVS-1)*VSLOT)?0:vs_next+VSLOT; }while(0)
  if(mp==0){ DMA_K(2,2*KSLOT); WAIT_BAR(4); }
  else { WAIT_BAR(0); }
  { _Pragma("unroll") for(int i=0;i<8;++i)kf[i]=kld(kp0,i);
    pA0=MFMA32(kf[0],qr[0],zero16);pA1=MFMA32(kf[1],qr[0],zero16);pA0=MFMA32(kf[2],qr[1],pA0);pA1=MFMA32(kf[3],qr[1],pA1);
    pA0=MFMA32(kf[4],qr[2],pA0);pA1=MFMA32(kf[5],qr[2],pA1);pA0=MFMA32(kf[6],qr[3],pA0);pA1=MFMA32(kf[7],qr[3],pA1); }
  CMASK(pA0,pA1,0);
  { mhat=rowmax(pA0,pA1);
    _Pragma("unroll") for(int r=0;r<16;++r){pA0[r]=__builtin_amdgcn_exp2f(pA0[r]-mhat);pA1[r]=__builtin_amdgcn_exp2f(pA1[r]-mhat);} }
  WAIT_BAR(0);
  DMA_K(3,3*KSLOT);DMA_V(1,VSLOT);
  ROT();
  { const lds_cptr kq_=kp0+ks_cur; kf[0]=kld(kq_,0);kf[1]=kld(kq_,1);kf[2]=kld(kq_,2);kf[3]=kld(kq_,3); }
  bf16x8 qa=QL(0),qb_;
  s16x4 vlo[8],vhi[8],wlo[8],whi[8]; u32x4 pw0,pw1,pw2,pw3;
  #define PKW(P,B) cvtpk_s(P[B],P[B+1])
  #define PAF(k) __builtin_bit_cast(bf16x8,pw##k)
  #define VFR(i) (bf16x8){vlo[i][0],vlo[i][1],vlo[i][2],vlo[i][3],vhi[i][0],vhi[i][1],vhi[i][2],vhi[i][3]}
  #define WFR(i) (bf16x8){wlo[i][0],wlo[i][1],wlo[i][2],wlo[i][3],whi[i][0],whi[i][1],whi[i][2],whi[i][3]}
  #define PIN(x) asm volatile("":"+v"(x))
  #define GAPA(MF,A0,A1,A2,A3,W0,W1,PW) do{ MF; sacc+=A0; sacc+=A1; sacc+=A2; sacc+=A3; PIN(sacc); W0; W1; PIN(PW); SBAR(); }while(0)
  #define EX(v) __builtin_amdgcn_exp2f((v)-mhat)
  #define GAPB(MF,X,B) do{ MF; X[B]=EX(X[B]); X[B+1]=EX(X[B+1]); PIN(X); SBAR(); }while(0)
  #define VRD(i) do{ vlo[i]=vtr(vp_+(((i)>>2)*4096+((i)&3)*1024)); vhi[i]=vtr(vp_+(((i)>>2)*4096+((i)&3)*1024+512)); }while(0)
  #define WRD(i) do{ wlo[i]=vtr(vp_+(8192+((i)>>2)*4096+((i)&3)*1024)); whi[i]=vtr(vp_+(8192+((i)>>2)*4096+((i)&3)*1024+512)); SBAR(); }while(0)
  #define KJ(i) do{ kf[i]=kld(kq_,i); }while(0)
  #define KRD(G,i) do{ if(G){ kf[i]=kld(kn_,i); SBAR(); } }while(0)
  #define STEP(C0,C1,P0,P1,t,GK,GV,GL) do{ SBAR(); \
    const lds_cptr vp_=vp0+vs_prev; const lds_cptr kq_=kp0+ks_cur; const lds_cptr kn_=kp0+ks_next; \
    VRD(0); KJ(4); qb_=QL(1); SBAR(); float sacc=(P0[0]+P0[1]); \
    GAPA(C0=MFMA32(kf[0],qa,zero16), P0[2],P0[3],P0[4],P0[5],     pw0[0]=PKW(P0,0), pw0[1]=PKW(P0,2), pw0); \
    VRD(4); KJ(5); SBAR(); GAPA(C1=MFMA32(kf[1],qa,zero16), P0[6],P0[7],P0[8],P0[9],     pw0[2]=PKW(P0,4), pw0[3]=PKW(P0,6), pw0); \
    VRD(1); KJ(6); qa=QL(2); SBAR(); GAPA(C0=MFMA32(kf[2],qb_,C0),   P0[10],P0[11],P0[12],P0[13], pw1[0]=PKW(P0,8), pw1[1]=PKW(P0,10), pw1); \
    VRD(5); KJ(7); SBAR(); GAPA(C1=MFMA32(kf[3],qb_,C1),   P0[14],P0[15],P1[0],P1[1],   pw1[2]=PKW(P0,12),pw1[3]=PKW(P0,14), pw1); \
    VRD(2); qb_=QL(3); SBAR(); GAPA(C0=MFMA32(kf[4],qa,C0),   P1[2],P1[3],P1[4],P1[5],     pw2[0]=PKW(P1,0), pw2[1]=PKW(P1,2), pw2); \
    VRD(6); SBAR(); GAPA(C1=MFMA32(kf[5],qa,C1),   P1[6],P1[7],P1[8],P1[9],     pw2[2]=PKW(P1,4), pw2[3]=PKW(P1,6), pw2); \
    VRD(3); SBAR(); GAPA(C0=MFMA32(kf[6],qb_,C0),   P1[10],P1[11],P1[12],P1[13], pw3[0]=PKW(P1,8), pw3[1]=PKW(P1,10), pw3); \
    VRD(7); SBAR(); GAPA(C1=MFMA32(kf[7],qb_,C1),   P1[14],P1[15],0.f,0.f,       pw3[2]=PKW(P1,12),pw3[3]=PKW(P1,14), pw3); \
    l_reg+=sacc; \
    if(GK){DMA_K((t)+3,(ks_cur==0)?(NKS-1)*KSLOT:ks_cur-KSLOT);} if(GV){DMA_V((t)+1,vs_next);} \
    CMASK(C0,C1,t); \
    { float rm=rowmax(C0,C1)-mhat; \
      resc=false; \
      if(__builtin_expect(__any(rm>(float)THRL),0)){ const float dl=__builtin_fmaxf(rm,0.f); mhat+=dl; \
        const float f=__builtin_amdgcn_exp2f(-dl); l_reg*=f; { const int lf_=fresh_lane(); if(lf_<32)((float*)(shm+LDS_WS))[wid*64+lf_]=f; } resc=true; } } \
    SBAR(); \
    GAPB(o[0]=MFMA32(PAF(0),VFR(0),o[0]), C0,0);  WRD(0); \
    GAPB(o[1]=MFMA32(PAF(0),VFR(4),o[1]), C0,2);  WRD(4); \
    GAPB(o[0]=MFMA32(PAF(1),VFR(1),o[0]), C0,4);  WRD(1); \
    GAPB(o[1]=MFMA32(PAF(1),VFR(5),o[1]), C0,6);  WRD(5); \
    GAPB(o[0]=MFMA32(PAF(2),VFR(2),o[0]), C0,8);  WRD(2); \
    GAPB(o[1]=MFMA32(PAF(2),VFR(6),o[1]), C0,10); WRD(6); \
    GAPB(o[0]=MFMA32(PAF(3),VFR(3),o[0]), C0,12); WRD(3); \
    GAPB(o[1]=MFMA32(PAF(3),VFR(7),o[1]), C0,14); WRD(7); \
    GAPB(o[2]=MFMA32(PAF(0),WFR(0),o[2]), C1,0); \
    GAPB(o[3]=MFMA32(PAF(0),WFR(4),o[3]), C1,2); \
    GAPB(o[2]=MFMA32(PAF(1),WFR(1),o[2]), C1,4); \
    GAPB(o[3]=MFMA32(PAF(1),WFR(5),o[3]), C1,6); \
    KRD(GL,0); GAPB(o[2]=MFMA32(PAF(2),WFR(2),o[2]), C1,8); \
    KRD(GL,1); GAPB(o[3]=MFMA32(PAF(2),WFR(6),o[3]), C1,10); \
    KRD(GL,2); GAPB(o[2]=MFMA32(PAF(3),WFR(3),o[2]), C1,12); \
    KRD(GL,3); if(GL){qa=QL(0);SBAR();} GAPB(o[3]=MFMA32(PAF(3),WFR(7),o[3]), C1,14); \
    }while(0)
  int t=1;
  #undef CMASK
  #define CMASK(P0,P1,t) do{}while(0)
  for(;t+5<NT;t+=2){
    STEP(pB0,pB1,pA0,pA1,t,true,true,true);     APB0(); APW(3); APB1(); WAIT_BAR(3); RESC(); ROT();
    STEP(pA0,pA1,pB0,pB1,t+1,true,true,true);   APB0(); APW(3); APB1(); WAIT_BAR(3); RESC(); ROT();
  }
  #undef CMASK
  #define CMASK(P0,P1,t) do{int jb_=(t)-(NT-4); if(jb_>=0){ const int lf_=fresh_lane(); cmask(P0,P1,jb_,wid*QBLK+(lf_&31),lf_>>5); } }while(0)
  #define ENDW(tt) do{ if((tt)+3<NT){WAIT_BAR(3);} else if((tt)+2<NT){WAIT_BAR(2);} else {WAIT_BAR(0);} }while(0)
  for(;t+1<NT;t+=2){
    STEP(pB0,pB1,pA0,pA1,t,(t+3<NT),(t+1<NT),(t+1<NT));       ENDW(t);   RESC(); ROT();
    STEP(pA0,pA1,pB0,pB1,t+1,(t+4<NT),(t+2<NT),(t+2<NT));     ENDW(t+1); RESC(); ROT();
  }
  STEP(pB0,pB1,pA0,pA1,NT-1,false,false,false); RESC();
  { float sacc=pB0[0]+pB0[1]; _Pragma("unroll") for(int r=2;r<16;++r)sacc+=pB0[r]; _Pragma("unroll") for(int r=0;r<16;++r)sacc+=pB1[r]; l_reg+=sacc;
    pw0=(u32x4){PKW(pB0,0),PKW(pB0,2),PKW(pB0,4),PKW(pB0,6)};pw1=(u32x4){PKW(pB0,8),PKW(pB0,10),PKW(pB0,12),PKW(pB0,14)};pw2=(u32x4){PKW(pB1,0),PKW(pB1,2),PKW(pB1,4),PKW(pB1,6)};pw3=(u32x4){PKW(pB1,8),PKW(pB1,10),PKW(pB1,12),PKW(pB1,14)};
    SBAR(); const lds_cptr vp_=vp0+vs_cur;
    _Pragma("unroll") for(int qd=0;qd<4;++qd){ s16x4 lo_[4],hi_[4];
      _Pragma("unroll") for(int ks=0;ks<4;++ks){ lo_[ks]=vtr(vp_+(qd*4096+ks*1024)); hi_[ks]=vtr(vp_+(qd*4096+ks*1024+512)); }
      #define PK_(k) (bf16x8){lo_[k][0],lo_[k][1],lo_[k][2],lo_[k][3],hi_[k][0],hi_[k][1],hi_[k][2],hi_[k][3]}
      o[qd]=MFMA32(PAF(0),PK_(0),o[qd]); o[qd]=MFMA32(PAF(1),PK_(1),o[qd]); o[qd]=MFMA32(PAF(2),PK_(2),o[qd]); o[qd]=MFMA32(PAF(3),PK_(3),o[qd]);
      #undef PK_
    } }
  #undef STEP
  #undef ENDW
  #undef CMASK
  asm volatile("s_waitcnt lgkmcnt(0)\n\ts_barrier":::"memory");
  unsigned pk_[32];
  if(mp==1){ int lp_=lane; asm volatile("":"+v"(lp_)); const unsigned*pp_=A.park+wid*2048+lp_;
    _Pragma("unroll") for(int i=0;i<32;++i)pk_[i]=pp_[i*64]; }
  if(mp==0){ kptr=A.K+rowbase*PQ+(h*2+1)*64; vptr=A.V+rowbase*PQ+h*128; DMA_K(0,0);DMA_V(0,0);DMA_K(1,KSLOT);DMA_K(2,2*KSLOT); }
  int le_=lane; asm volatile("":"+v"(le_)); const int r32e=le_&31,hie=le_>>5; float*wse=(float*)(shm+LDS_WS)+wid*64; unsigned*parke=A.park+wid*2048+le_;
  {auto rr=__builtin_amdgcn_permlane32_swap(__float_as_uint(l_reg),__float_as_uint(l_reg),false,false);l_reg=__uint_as_float(rr[0])+__uint_as_float(rr[1]);}
  if(hie==0)wse[32+r32e]=l_reg;asm volatile("s_waitcnt lgkmcnt(0)":::"memory");
  float rli[16];
  #pragma unroll
  for(int r=0;r<16;++r)rli[r]=__builtin_amdgcn_rcpf(wse[32+crow(r,hie)]);
  if(mp==0){
    #pragma unroll
    for(int d0=0;d0<4;++d0)
      #pragma unroll
      for(int r=0;r<16;r+=2)parke[(d0*8+(r>>1))*64]=cvtpk_s(o[d0][r]*rli[r],o[d0][r+1]*rli[r+1]);
  } else {
    float ss[16];
    #pragma unroll
    for(int r=0;r<16;++r)ss[r]=0.f;
    #pragma unroll
    for(int d0=0;d0<4;++d0)
      #pragma unroll
      for(int r=0;r<16;r+=2){ const unsigned w=pk_[d0*8+(r>>1)];
        const float d_lo=__uint_as_float(w<<16)-A.lam*(o[d0][r]*rli[r]), d_hi=__uint_as_float(w&0xffff0000u)-A.lam*(o[d0][r+1]*rli[r+1]);
        o[d0][r]=d_lo; o[d0][r+1]=d_hi; ss[r]+=d_lo*d_lo; ss[r+1]+=d_hi*d_hi; }
    float gn[4];
    #pragma unroll
    for(int d0=0;d0<4;++d0)gn[d0]=A.subln[32*d0+r32e]*A.post;
    #pragma unroll
    for(int r=0;r<16;++r){ float s=ss[r];
      s+=__int_as_float(__builtin_amdgcn_update_dpp(0,__float_as_int(s),0x128,0xf,0xf,false));
      s+=__int_as_float(__builtin_amdgcn_update_dpp(0,__float_as_int(s),0x124,0xf,0xf,false));
      s+=__int_as_float(__builtin_amdgcn_update_dpp(0,__float_as_int(s),0x122,0xf,0xf,false));
      s+=__int_as_float(__builtin_amdgcn_update_dpp(0,__float_as_int(s),0x121,0xf,0xf,false));
      auto rr=__builtin_amdgcn_permlane16_swap(__float_as_uint(s),__float_as_uint(s),false,false);
      ss[r]=__builtin_amdgcn_rsqf((__uint_as_float(rr[0])+__uint_as_float(rr[1]))*(1.0f/128.0f)+1e-6f); }
    bf16*stg=(bf16*)(shm+LDS_Q+wid*4096);
    bf16*Ow=A.MIX+(rowbase+q0+wid*QBLK)*PM+512+h*128;
    const int lo_=le_; const unsigned ooff_=(unsigned)((lo_>>3)*PM+(lo_&7)*8);
    #pragma unroll
    for(int hf=0;hf<2;++hf){
      #pragma unroll
      for(int r=0;r<16;++r){ const int orow=crow(r,hie);
        #pragma unroll
        for(int d0=0;d0<2;++d0)((unsigned short*)stg)[orow*64+d0*32+r32e]=(unsigned short)cvtpk_s(o[2*hf+d0][r]*ss[r]*gn[2*hf+d0],0.f); }
      asm volatile("s_waitcnt lgkmcnt(0)":::"memory");
      _Pragma("unroll") for(int i=0;i<4;++i){const int row=i*8+(lo_>>3),ch=lo_&7; const u32x4 v=*(const u32x4*)(stg+row*64+ch*8); *(u32x4*)(Ow+ooff_+i*8*PM+hf*64)=v;}
      asm volatile("s_waitcnt lgkmcnt(0)":::"memory");
    }
  }
  ATTN_PROBE_OUT();
  #undef DMA_K
  #undef DMA_V
  #undef RESC
  #undef ROT
  #undef PKW
  #undef PAF
  #undef VFR
  #undef WFR
  #undef PIN
  #undef GAPA
  #undef GAPB
  #undef EX
  #undef VRD
  #undef WRD
  #undef KJ
  #undef KRD
  }
}
constexpr int ATTN_LDS_BYTES=LDS_BYTES;
template<int THRL=8> __device__ __forceinline__ void attn_phase(char*lds,const AttnArgs&A,int vcu,int G,const int tid){
  for(int slot=vcu;slot<256;slot+=G){ const int bh=slot>>3,s=slot&7;
    attn_unit<THRL>(tid,bh>>2,bh&3,15-s,A,lds); attn_unit<THRL>(tid,bh>>2,bh&3,s,A,lds); }
}
#undef SBAR
#undef WAIT_BAR
#undef MX3
#undef MFMA32
}
namespace cg = cooperative_groups;
#define GAS __attribute__((address_space(1)))
#define LAS __attribute__((address_space(3)))
typedef unsigned short bf16;
typedef unsigned v4u __attribute__((ext_vector_type(4)));
typedef unsigned v2u __attribute__((ext_vector_type(2)));
typedef float f32x4 __attribute__((ext_vector_type(4)));
typedef short bf16x8 __attribute__((ext_vector_type(8)));

constexpr int NB = 8, SEQ = 4096, M = NB * SEQ, DMODEL = 1024, DEPTH = 2;
constexpr int D_SGU = 512, D_ATT = 512, D_IN = 2560, D_FF = 2816, NUP = 2 * D_FF;
constexpr float EPS = 1e-6f;
constexpr float C2 = 0.125f * 1.4426950408889634f;
constexpr size_t MiB = 1u << 20;
constexpr size_t WS_W = 1 * MiB, W_LAYER = 24 * MiB;
constexpr size_t W_IN = 0, W_OUT = 5 * MiB, W_UP = 7 * MiB, W_DN = 18 * MiB;
constexpr size_t WS_COS = 49 * MiB, WS_SIN = 50 * MiB;
constexpr size_t WS_PART = 51 * MiB;
constexpr size_t WS_TOP = 53 * MiB, WS_BOT = 75 * MiB;
constexpr size_t WS_HB = 97 * MiB;
constexpr size_t WS_MIX = 161 * MiB;
constexpr size_t WS_R = 225 * MiB;
constexpr size_t SEG = (size_t)M * 512;
constexpr size_t WS_O = WS_R + 5 * SEG * 2;
constexpr size_t WS_END = WS_O + (size_t)M * 1024 * 2;
constexpr size_t WS_PARK = 449 * MiB;
constexpr size_t WS_TOTAL = WS_PARK + 16 * MiB;
static_assert(WS_END == 449 * MiB && WS_R + (size_t)M * pg8::ACT_LD * 2 <= WS_END && (size_t)DMODEL * pg8::ACT_LD * 2 <= 6 * MiB, "d_ws map");
constexpr size_t WS_CTL = 0; constexpr int CW_BAR = 4096;
constexpr int XCH_OFF = 131072;
constexpr int MISC_OFF = 150528;
constexpr int LDS_BYTES = 151552;
constexpr int NPH = 16;

__device__ __forceinline__ float bf2f(unsigned b) { return __uint_as_float(b << 16); }
__device__ __forceinline__ unsigned pk2(float lo, float hi) { return pg8::cvt_pk_bf16(lo, hi); }
__device__ __forceinline__ float shx(float v, int lane, int mask) { return __int_as_float(__builtin_amdgcn_ds_bpermute(4 * (lane ^ mask), __float_as_int(v))); }
__device__ __forceinline__ float wave_sum(float v, int lane) {
#pragma unroll
    for (int o = 1; o < 64; o <<= 1) v += shx(v, lane, o);
    return v;
}
#define LDS_WAIT() asm volatile("s_waitcnt lgkmcnt(0)" ::: "memory")

#define RLX_AGENT __ATOMIC_RELAXED, __HIP_MEMORY_SCOPE_AGENT
#define XB_TMO      128
#define XB_XCNT(j)  (256  + 64 * (j))
#define XB_XSUB(j)  (1280 + 64 * (j))
#define XB_XGEN(j)  (2304 + 64 * (j))
#define XB_TOP      3328
#define XB_TOPGEN   3392
#define XCD_BAR_WORDS 3456
#define XB_SPIN_CAP (1u << 18)

__device__ __forceinline__ unsigned xb_ld(unsigned* p)              { return __hip_atomic_load(p, __ATOMIC_RELAXED, __HIP_MEMORY_SCOPE_AGENT); }
__device__ __forceinline__ unsigned xb_add(unsigned* p, unsigned v) { return __hip_atomic_fetch_add(p, v, __ATOMIC_RELAXED, __HIP_MEMORY_SCOPE_AGENT); }
__device__ __forceinline__ unsigned xb_xcc_id() { return (unsigned)__builtin_amdgcn_s_getreg((3 << 11) | 20) & 0xFu; }
#define XB_SPIN(cond, bar) do { unsigned _sp = 0; while (cond) { __builtin_amdgcn_s_sleep(1); \
    if ((++_sp & 255u) == 0u) { if (xb_ld(&(bar)[XB_TMO])) break; if (_sp > XB_SPIN_CAP) { atomicAdd(&(bar)[XB_TMO], 1u); break; } } } } while (0)

struct XcdBarrier {
    unsigned* bar; unsigned x;
    volatile LAS unsigned* st;
};

__device__ __forceinline__ XcdBarrier xcd_barrier_post(unsigned* bar, volatile LAS unsigned* st, bool is_t0) {
    XcdBarrier b; b.bar = bar; b.x = xb_xcc_id(); b.st = st;
    if (is_t0) (void)xb_add(&bar[XB_XCNT(b.x)], 1u);
    return b;
}
__device__ __forceinline__ void xcd_barrier_complete(unsigned* bar, unsigned x, unsigned& nloc, unsigned& nx) {
    const unsigned G = gridDim.x * gridDim.y * gridDim.z;
    unsigned sum, cnt, mine, sp = 0u;
    for (;;) {
        sum = 0u; cnt = 0u; mine = 0u;
#pragma unroll
        for (unsigned j = 0; j < 16; ++j) { const unsigned c = xb_ld(&bar[XB_XCNT(j)]); sum += c; cnt += (c > 0u) ? 1u : 0u; mine = (j == x) ? c : mine; }
        if (sum == G) break;
        __builtin_amdgcn_s_sleep(1);
        if ((++sp & 255u) == 0u) { if (xb_ld(&bar[XB_TMO])) break; if (sp > XB_SPIN_CAP) { atomicAdd(&bar[XB_TMO], 1u); break; } }
    }
    nloc = mine > 0u ? mine : 1u; nx = cnt > 0u ? cnt : 1u;
}

__device__ __forceinline__ void xcd_barrier(const XcdBarrier& b, bool is_t0) {
    asm volatile("s_waitcnt vmcnt(0)" ::: "memory");
    __syncthreads();
    if (is_t0) {
        unsigned* bar = b.bar;
        __builtin_amdgcn_s_waitcnt(0);
        unsigned nloc = b.st[0], nx = b.st[1];
        if (nloc == 0u) { xcd_barrier_complete(bar, b.x, nloc, nx); b.st[0] = nloc; b.st[1] = nx; }
        const unsigned old = xb_add(&bar[XB_XSUB(b.x)], 1u);
        const unsigned gen = old / nloc;
        if (old + 1u == (gen + 1u) * nloc) {
            __builtin_amdgcn_fence(__ATOMIC_RELEASE, "agent");
            asm volatile("s_waitcnt vmcnt(0)" ::: "memory");
            const unsigned og = xb_add(&bar[XB_TOP], 1u);
            const unsigned tg = og / nx;
            if (og + 1u == (tg + 1u) * nx) xb_add(&bar[XB_TOPGEN], 1u);
            else XB_SPIN(xb_ld(&bar[XB_TOPGEN]) == tg, bar);
            __builtin_amdgcn_fence(__ATOMIC_ACQUIRE, "agent");
            xb_add(&bar[XB_XGEN(b.x)], 1u);
            asm volatile("s_waitcnt vmcnt(0)" ::: "memory");
        } else {
            XB_SPIN(xb_ld(&bar[XB_XGEN(b.x)]) == gen, bar);
            __builtin_amdgcn_fence(__ATOMIC_ACQUIRE, "agent");
            asm volatile("s_waitcnt vmcnt(0)" ::: "memory");
        }
    }
    __syncthreads();
}


template <int MODE> __device__ __forceinline__ int wrow_map(int n) {
    if (MODE == 1) { if (n >= 1024 && n < 2048) { const int d = n & 63; if (d < 16) return (n - d) + (d < 8 ? 2 * d : 2 * (d - 8) + 1); } return n; }
    if (MODE == 2) { return n < D_FF ? (n >> 7) * 256 + (n & 127) : ((n - D_FF) >> 7) * 256 + 128 + ((n - D_FF) & 127); }
    return n;
}
template <int MODE> __device__ __forceinline__ void p0_transpose_item(const float* W, const float* gk, int K, int N, bf16* WT, LAS float* scr, int item, int lane, int ldw = 0) {
    const int nblk = N / 32, kb = item / nblk, nb = item % nblk, k0 = 64 * kb, n0 = 32 * nb;
    float wv[32];
#pragma unroll
    for (int i = 0; i < 32; ++i) wv[i] = W[(size_t)(k0 + 2 * i + (lane >> 5)) * N + n0 + (lane & 31)];
#pragma unroll
    for (int i = 0; i < 32; ++i) scr[(2 * i + (lane >> 5)) * 33 + (lane & 31)] = wv[i];
    LDS_WAIT(); asm volatile("" ::: "memory");
    const int c = lane & 7;
    f32x4 ga = {1.f, 1.f, 1.f, 1.f}, gb = {1.f, 1.f, 1.f, 1.f};
    if (gk) { ga = *(const f32x4*)(gk + k0 + 8 * c); gb = *(const f32x4*)(gk + k0 + 8 * c + 4); }
#pragma unroll
    for (int j = 0; j < 4; ++j) { const int n = (lane >> 3) + 8 * j; const LAS float* s = scr + (8 * c) * 33 + n;
        v4u o; o.x = pk2(s[0 * 33] * ga[0], s[1 * 33] * ga[1]); o.y = pk2(s[2 * 33] * ga[2], s[3 * 33] * ga[3]); o.z = pk2(s[4 * 33] * gb[0], s[5 * 33] * gb[1]); o.w = pk2(s[6 * 33] * gb[2], s[7 * 33] * gb[3]);
        *(v4u*)(WT + (size_t)wrow_map<MODE>(n0 + n) * (ldw ? ldw : K) + k0 + 8 * c) = o; }
    LDS_WAIT(); asm volatile("" ::: "memory");
}

__device__ __forceinline__ const void* karg(int i) {
    unsigned off = 8u * (unsigned)i; asm volatile("" : "+s"(off));
    return *(const void* const __attribute__((address_space(4)))*)((const char __attribute__((address_space(4)))*)__builtin_amdgcn_kernarg_segment_ptr() + off);
}
#define KIN(i) ((const float*)karg(i))
#define KOUT() ((float*)karg(19))
#define KWS() ((unsigned char*)karg(20))
#ifndef MK_MASK
#define MK_MASK 0x3ff
#endif
#define HAVE(k) (((MK_MASK) >> (k)) & 1)
#ifndef MK_TSOFF
#define MK_TSOFF 0
#endif
#if MK_TS >= 0
#define MK_STAMP(k, t0) do { if ((t0) && blockIdx.x == 0) { ((unsigned long long*)(KWS() + 65536))[(k) + 1] = __builtin_amdgcn_s_memrealtime(); ((unsigned long long*)(KWS() + 65536))[(k) + 33] = __builtin_readcyclecounter(); } } while (0)
#else
#define MK_STAMP(k, t0) do {} while (0)
#endif
#define MK_IDS \
    int zz_; asm volatile("s_mov_b32 %0, 0" : "=s"(zz_)); \
    const int lane = __builtin_amdgcn_mbcnt_hi(~0u, __builtin_amdgcn_mbcnt_lo(~0u, (unsigned)zz_)), wave = wave_s; const int tid = wave * 64 + lane; \
    int G = gridDim.x, bx = blockIdx.x; asm volatile("" : "+s"(G), "+s"(bx)); \
    const int vcu = (G % 8 == 0) ? (bx % 8) * (G / 8) + bx / 8 : bx;     \
    const int gw = vcu * 8 + wave, NGW = G * 8; (void)lane; (void)gw; (void)NGW; (void)vcu; (void)tid;
struct Args { const void* in[19]; float* out; unsigned char* ws; int ph_lo, ph_hi; };

__global__ void __launch_bounds__(512, 2) mk_fwd(Args args) {
    extern __shared__ __attribute__((aligned(16))) unsigned char lds[];
    cg::grid_group grid = cg::this_grid();
    int wave_s; { const int t0_ = threadIdx.x; wave_s = __builtin_amdgcn_readfirstlane(t0_ >> 6); asm volatile("" : "+s"(wave_s));
        if (t0_ < 16) ((volatile LAS unsigned*)((LAS unsigned char*)lds + MISC_OFF))[t0_] = 0u;
        if (args.ph_lo < 0) grid.sync();
        __syncthreads(); }
    { const bool t0b_ = (wave_s == 0) && (__builtin_amdgcn_mbcnt_hi(~0u, __builtin_amdgcn_mbcnt_lo(~0u, 0u)) == 0);
      (void)xcd_barrier_post((unsigned*)(args.ws + WS_CTL) + CW_BAR, (volatile LAS unsigned*)((LAS unsigned char*)lds + MISC_OFF) + 8, t0b_); }
    const int lo = args.ph_lo, hi = args.ph_hi;
#if MK_TS >= 0
    if (wave_s == 0 && blockIdx.x == 0 && __builtin_amdgcn_mbcnt_hi(~0u, __builtin_amdgcn_mbcnt_lo(~0u, 0u)) == 0) ((unsigned long long*)(args.ws + 65536))[0] = __builtin_amdgcn_s_memrealtime();
#endif
#define IN(k) (lo <= (k) && (k) < hi)
#define SEAM(k) do { if (IN(k) && IN((k) + 1)) { int zb_; asm volatile("s_mov_b32 %0, 0" : "=s"(zb_)); \
        const bool t0b_ = (wave_s == 0) && (__builtin_amdgcn_mbcnt_hi(~0u, __builtin_amdgcn_mbcnt_lo(~0u, (unsigned)zb_)) == 0); \
        XcdBarrier xb_; xb_.bar = (unsigned*)(KWS() + WS_CTL) + CW_BAR; xb_.x = xb_xcc_id(); xb_.st = (volatile LAS unsigned*)((LAS unsigned char*)lds + MISC_OFF) + 8; xcd_barrier(xb_, t0b_); MK_STAMP(k, t0b_); } } while (0)

    if (HAVE(0) && IN(0)) {
        MK_IDS
        LAS float* scr = (LAS float*)((LAS unsigned char*)lds + wave * 16384);
        unsigned char* ws = KWS(); const float* w_in = KIN(3); const float* w_out = KIN(12); const float* w_up = KIN(14); const float* w_down = KIN(17);
        constexpr int I_IN = (DMODEL / 64) * (D_IN / 32), I_OUT = (DMODEL / 64) * (DMODEL / 32), I_UP = (DMODEL / 64) * (NUP / 32), I_DN = (D_FF / 64) * (DMODEL / 32);
        constexpr int I_L = I_IN + I_OUT + I_UP + I_DN;
        for (int it = gw; it < DEPTH * I_L; it += NGW) {
            const int l = it / I_L; int r = it % I_L; unsigned char* wl = ws + WS_W + (size_t)l * W_LAYER;
            if (r < I_IN) { p0_transpose_item<1>(w_in + (size_t)l * DMODEL * D_IN, KIN(2) + (size_t)l * DMODEL, DMODEL, D_IN, (bf16*)(wl + W_IN), scr, r, lane); continue; } r -= I_IN;
            if (r < I_OUT) { p0_transpose_item<0>(w_out + (size_t)l * DMODEL * DMODEL, nullptr, DMODEL, DMODEL, (bf16*)(wl + W_OUT), scr, r, lane); continue; } r -= I_OUT;
            if (r < I_UP) { p0_transpose_item<2>(w_up + (size_t)l * DMODEL * NUP, KIN(13) + (size_t)l * DMODEL, DMODEL, NUP, (bf16*)(wl + W_UP), scr, r, lane); continue; } r -= I_UP;
            p0_transpose_item<0>(w_down + (size_t)l * D_FF * DMODEL, nullptr, D_FF, DMODEL, (bf16*)(wl + W_DN), scr, r, lane, pg8::ACT_LD);
        }
        const float* x = KIN(0); const int* positions = (const int*)karg(1);
        bf16* HB = (bf16*)(ws + WS_HB); float* PART = (float*)(ws + WS_PART); float* COS = (float*)(ws + WS_COS); float* SIN = (float*)(ws + WS_SIN);
        for (int m0 = gw; m0 < M; m0 += 4 * NGW) {
            f32x4 v[4][4]; int pos[4];
#pragma unroll
            for (int k = 0; k < 4; ++k) { const int m = (m0 + k * NGW < M) ? m0 + k * NGW : m0; const f32x4* xr = (const f32x4*)(x + (size_t)m * DMODEL) + lane;
#pragma unroll
                for (int j = 0; j < 4; ++j) v[k][j] = xr[64 * j];
                pos[k] = positions[m]; }
#pragma unroll
            for (int k = 0; k < 4; ++k) { const int m = m0 + k * NGW; if (m < M) {
                unsigned long long* o8 = (unsigned long long*)(HB + (size_t)m * DMODEL) + lane; float s = 0.f;
#pragma unroll
                for (int j = 0; j < 4; ++j) { const f32x4 w = v[k][j]; s += (w.x * w.x + w.y * w.y) + (w.z * w.z + w.w * w.w);
                    o8[64 * j] = (unsigned long long)pk2(w.x, w.y) | ((unsigned long long)pk2(w.z, w.w) << 32); }
                s = wave_sum(s, lane);
                if (lane < 4) PART[(size_t)m * 4 + lane] = (lane == 0) ? s : 0.f;
                if (lane < 8) {
                    const float inv_freq = exp2f(-(float)lane * 0.125f * 18.931568569324174f);
                    const float ang = (float)pos[k] * inv_freq;
                    const double rev = (double)ang * 0.15915494309189535; const float fr = (float)(rev - rint(rev));
                    COS[(size_t)m * 8 + lane] = __builtin_amdgcn_cosf(fr); SIN[(size_t)m * 8 + lane] = __builtin_amdgcn_sinf(fr);
                } } }
        }
    }
    SEAM(0);

    for (int l = 0; l < DEPTH; ++l) {
        const int pb = 1 + 7 * l;
        const float lambda_init = (l == 0) ? 0.2f : 0.35550906759096314f;
        if (HAVE(1) && IN(pb + 0)) {
            MK_IDS
            unsigned char* ws = KWS(); unsigned char* wl = ws + WS_W + (size_t)l * W_LAYER;
            pg8::Gemm g{(const bf16*)(ws + WS_HB), (const bf16*)(wl + W_IN), M, D_IN, DMODEL, DMODEL}; pg8::StaticOrder S; S.init(M, D_IN, G, bx);
            pg8::EpiInProj E{(const float*)(ws + WS_PART), (const float*)(ws + WS_COS), (const float*)(ws + WS_SIN), (bf16*)(ws + WS_R), C2, SEG, (LAS unsigned char*)lds};
            pg8::gemm_phase<pg8::EpiInProj, pg8::StaticOrder, true, true>((LAS unsigned char*)lds, g, S, E, tid);
        }
        SEAM(pb + 0);
        if (IN(pb + 1)) {
            {
            MK_IDS
            unsigned char* ws = KWS(); bf16* R = (bf16*)(ws + WS_R); bf16* MIX = (bf16*)(ws + WS_MIX);
            float d1 = KIN(7)[l * 64 + lane] * KIN(8)[l * 64 + lane], d2 = KIN(9)[l * 64 + lane] * KIN(10)[l * 64 + lane];
            d1 = wave_sum(d1, lane); d2 = wave_sum(d2, lane);
            const attn_body::AttnArgs AT{(const attn_body::bf16*)(R + 2 * SEG), (const attn_body::bf16*)(R + 3 * SEG), (const attn_body::bf16*)(R + 4 * SEG), (attn_body::bf16*)MIX,
                                         KIN(11) + l * 128, (unsigned*)(ws + WS_PARK) + (size_t)bx * 16384, expf(d1) - expf(d2) + lambda_init, 1.0f - lambda_init};
            static_assert(attn_body::ATTN_LDS_BYTES <= MISC_OFF, "attention LDS vs control words");
            if (HAVE(2)) attn_body::attn_phase<8>((char*)lds, AT, vcu, G, tid);
            }
            MK_IDS
            unsigned char* ws = KWS(); bf16* R = (bf16*)(ws + WS_R); bf16* MIX = (bf16*)(ws + WS_MIX);
            const bf16* U = R; const bf16* VS = R + SEG;
            LAS bf16* vimg = (LAS bf16*)lds;
            LAS float* rsq = (LAS float*)((LAS unsigned char*)lds + 36864);
            const float* Wg_l = KIN(5) + (size_t)l * 4 * 128 * 128; const float* bs_l = KIN(6) + (size_t)l * 4 * 128; const float* vn_l = KIN(4) + (size_t)l * D_SGU;
            if (HAVE(3)) {
                const int p = 16 * wave + (lane & 15), kq = 8 * (lane >> 4); const int nks = (wave >> 1) + 1; const int dch = tid & 15;
                v4u raw[4];
                int unit = vcu;
                { const int u0 = unit < NB * 32 * 4 ? unit : 0; const int g = u0 & 3, t0 = (u0 >> 7) * SEQ + ((u0 >> 2) & 31) * 128;
#pragma unroll
                    for (int i = 0; i < 4; ++i) raw[i] = *(const v4u*)(VS + (size_t)(t0 + (tid >> 4) + 32 * i) * 512 + g * 128 + 8 * dch); }
                for (; unit < NB * 32 * 4; unit += G) {
                    const int g = unit & 3, ck = (unit >> 2) & 31, b = unit >> 7; const int t0 = b * SEQ + ck * 128;
                    float wreg[4][8]; const float bias = bs_l[g * 128 + p];
#pragma unroll
                    for (int ks = 0; ks < 4; ++ks) { const int q0 = 32 * ks + kq; const float* wp = Wg_l + ((size_t)g * 128 + p) * 128 + q0;
                        f32x4 w0 = {0.f, 0.f, 0.f, 0.f}, w1 = {0.f, 0.f, 0.f, 0.f};
                        if (ks < nks) { w0 = *(const f32x4*)wp; w1 = *(const f32x4*)(wp + 4); }
#pragma unroll
                        for (int jj = 0; jj < 8; ++jj) { const float w = jj < 4 ? w0[jj] : w1[jj - 4]; wreg[ks][jj] = (q0 + jj > p) ? 0.f : w; } }
                    v4u ur[4];
#pragma unroll
                    for (int k = 0; k < 4; ++k) ur[k] = *(const v4u*)(U + (size_t)(t0 + p) * 512 + g * 128 + 32 * k + 8 * (lane >> 4));
                    const f32x4 ga = *(const f32x4*)(vn_l + g * 128 + 8 * dch), gb = *(const f32x4*)(vn_l + g * 128 + 8 * dch + 4);
#pragma unroll
                    for (int i = 0; i < 4; ++i) { const int q = (tid >> 4) + 32 * i; const v4u r = raw[i];
                        const float f0 = bf2f(r.x & 0xffffu), f1 = bf2f(r.x >> 16), f2 = bf2f(r.y & 0xffffu), f3 = bf2f(r.y >> 16), f4 = bf2f(r.z & 0xffffu), f5 = bf2f(r.z >> 16), f6 = bf2f(r.w & 0xffffu), f7 = bf2f(r.w >> 16);
                        float ss = ((f0 * f0 + f1 * f1) + (f2 * f2 + f3 * f3)) + ((f4 * f4 + f5 * f5) + (f6 * f6 + f7 * f7));
                        ss += shx(ss, lane, 1); ss += shx(ss, lane, 2); ss += shx(ss, lane, 4); ss += shx(ss, lane, 8);
                        v4u sg; sg.x = pk2(f0 * ga[0], f1 * ga[1]); sg.y = pk2(f2 * ga[2], f3 * ga[3]); sg.z = pk2(f4 * gb[0], f5 * gb[1]); sg.w = pk2(f6 * gb[2], f7 * gb[3]);
                        { LAS bf16* vq = vimg + q * 136 + 32 * (dch >> 2) + 4 * (dch & 3);
                          v2u s0, s1; s0.x = sg.x; s0.y = sg.y; s1.x = sg.z; s1.y = sg.w; *(LAS v2u*)vq = s0; *(LAS v2u*)(vq + 16) = s1; }
                        if (dch == 0) rsq[q] = __builtin_amdgcn_rsqf(ss * (1.0f / 128.0f) + EPS);
                    }
                    { const int un = unit + G < NB * 32 * 4 ? unit + G : unit; const int gn_ = un & 3, tn = (un >> 7) * SEQ + ((un >> 2) & 31) * 128;
#pragma unroll
                        for (int i = 0; i < 4; ++i) raw[i] = *(const v4u*)(VS + (size_t)(tn + (tid >> 4) + 32 * i) * 512 + gn_ * 128 + 8 * dch); }
                    asm volatile("s_waitcnt lgkmcnt(0)\n\ts_barrier" ::: "memory");
                    f32x4 acc[8];
#pragma unroll
                    for (int nb = 0; nb < 8; ++nb) acc[nb] = (f32x4){0.f, 0.f, 0.f, 0.f};
                    const LAS bf16* ta = vimg + (kq + ((lane & 15) >> 2)) * 136 + 4 * (lane & 3);
#pragma unroll
                    for (int ks = 0; ks < 4; ++ks) if (ks < nks) {
                        const int q0 = 32 * ks + kq;
                        const f32x4 r0 = *(const LAS f32x4*)(rsq + q0), r1 = *(const LAS f32x4*)(rsq + q0 + 4);
                        v4u wb; wb.x = pk2(wreg[ks][0] * r0[0], wreg[ks][1] * r0[1]); wb.y = pk2(wreg[ks][2] * r0[2], wreg[ks][3] * r0[3]); wb.z = pk2(wreg[ks][4] * r1[0], wreg[ks][5] * r1[1]); wb.w = pk2(wreg[ks][6] * r1[2], wreg[ks][7] * r1[3]);
                        const bf16x8 bfrag = __builtin_bit_cast(bf16x8, wb);
#pragma unroll
                        for (int nb = 0; nb < 8; ++nb) {
                            typedef short s16x4_t __attribute__((ext_vector_type(4)));
                            const s16x4_t lo = __builtin_bit_cast(s16x4_t, __builtin_amdgcn_ds_read_tr16_b64_v4i16((LAS s16x4_t*)(ta + (32 * ks) * 136 + 16 * nb)));
                            const s16x4_t hi = __builtin_bit_cast(s16x4_t, __builtin_amdgcn_ds_read_tr16_b64_v4i16((LAS s16x4_t*)(ta + (32 * ks + 4) * 136 + 16 * nb)));
                            const bf16x8 afrag = (bf16x8){lo[0], lo[1], lo[2], lo[3], hi[0], hi[1], hi[2], hi[3]};
                            acc[nb] = __builtin_amdgcn_mfma_f32_16x16x32_bf16(afrag, bfrag, acc[nb], 0, 0, 0);
                        }
                    }
#pragma unroll
                    for (int k = 0; k < 4; ++k) { const int d = 32 * k + 8 * (lane >> 4); const f32x4 a0 = acc[2 * k], a1 = acc[2 * k + 1]; const v4u uu = ur[k];
                        const float y0 = bf2f(uu.x & 0xffffu) * (a0[0] + bias), y1 = bf2f(uu.x >> 16) * (a0[1] + bias), y2 = bf2f(uu.y & 0xffffu) * (a0[2] + bias), y3 = bf2f(uu.y >> 16) * (a0[3] + bias);
                        const float y4 = bf2f(uu.z & 0xffffu) * (a1[0] + bias), y5 = bf2f(uu.z >> 16) * (a1[1] + bias), y6 = bf2f(uu.w & 0xffffu) * (a1[2] + bias), y7 = bf2f(uu.w >> 16) * (a1[3] + bias);
                        v4u o; o.x = pk2(y0, y1); o.y = pk2(y2, y3); o.z = pk2(y4, y5); o.w = pk2(y6, y7);
                        *(v4u*)(MIX + (size_t)(t0 + p) * 1024 + g * 128 + d) = o; }
                    asm volatile("s_waitcnt lgkmcnt(0)\n\ts_barrier" ::: "memory");
                }
            }
        }
        SEAM(pb + 1);
        if (HAVE(5) && IN(pb + 3)) {
            MK_IDS
            unsigned char* ws = KWS(); unsigned char* wl = ws + WS_W + (size_t)l * W_LAYER;
            pg8::Gemm g{(const bf16*)(ws + WS_MIX), (const bf16*)(wl + W_OUT), M, DMODEL, DMODEL, DMODEL}; pg8::StaticOrder S; S.init(M, DMODEL, G, bx);
            pg8::EpiResid E{(bf16*)(ws + WS_HB), (float*)(ws + WS_PART), (LAS float*)((LAS unsigned char*)lds + XCH_OFF)};
            pg8::gemm_phase<pg8::EpiResid, pg8::StaticOrder, true, true, true>((LAS unsigned char*)lds, g, S, E, tid);
        }
        SEAM(pb + 3);
        if (HAVE(6) && IN(pb + 4)) {
            MK_IDS
            unsigned char* ws = KWS(); unsigned char* wl = ws + WS_W + (size_t)l * W_LAYER;
            pg8::Gemm g{(const bf16*)(ws + WS_HB), (const bf16*)(wl + W_UP), M, NUP, DMODEL, DMODEL}; pg8::StaticOrder S; S.init(M, NUP, G, bx);
            pg8::EpiUp E{(const float*)(ws + WS_PART), KIN(15) + (size_t)l * 3 * NUP, KIN(16) + (size_t)l * NUP, (bf16*)(ws + WS_R), (bf16*)(ws + WS_TOP), (bf16*)(ws + WS_BOT), (LAS unsigned char*)lds};
            pg8::gemm_phase<pg8::EpiUp, pg8::StaticOrder, true, true, true>((LAS unsigned char*)lds, g, S, E, tid);
        }
        SEAM(pb + 4);
        if (HAVE(7) && IN(pb + 5)) {
            MK_IDS
            unsigned char* ws = KWS(); const bf16* TOP = (const bf16*)(ws + WS_TOP); const bf16* BOT = (const bf16*)(ws + WS_BOT); bf16* ACT = (bf16*)(ws + WS_R);
            const float* cw = KIN(15) + (size_t)l * 3 * NUP; const float* cb = KIN(16) + (size_t)l * NUP;
            const int T = bx * 512 + tid, cq = T % 704, rg = T / 704; const int NRG = (G * 512) / 704;
            if (rg < NRG) {
                const int c = 4 * cq;
                const f32x4 kb_g = *(const f32x4*)(cb + c), k2_g = *(const f32x4*)(cw + 2 * 5632 + c), k1_g = *(const f32x4*)(cw + 5632 + c), k0_g = *(const f32x4*)(cw + c);
                const f32x4 kb_v = *(const f32x4*)(cb + 2816 + c), k2_v = *(const f32x4*)(cw + 2 * 5632 + 2816 + c), k1_v = *(const f32x4*)(cw + 5632 + 2816 + c), k0_v = *(const f32x4*)(cw + 2816 + c);
                constexpr int NIT = 6;
                f32x4 g2[NIT], g1[NIT], g0[NIT], v2[NIT], v1[NIT], v0[NIT]; float m1[NIT], m0[NIT]; int rowi[NIT];
#pragma unroll
                for (int it = 0; it < NIT; ++it) {
                    const int ri = rg + NRG * it; const bool valid = ri < 1024; const int rc = valid ? ri : rg;
                    const int blk = rc >> 1, rr = rc & 1; const bool first = (blk & 63) == 0; const int bp = first ? blk : blk - 1;
                    const bf16* t0 = TOP + (size_t)(blk * 2) * 5632 + c; const bf16* t1 = t0 + 5632;
                    const bf16* b0 = BOT + (size_t)(bp * 2) * 5632 + c; const bf16* b1 = b0 + 5632;
                    const bf16* p2 = rr ? t1 : t0; const bf16* p1 = rr ? t0 : b1; const bf16* p0 = rr ? b1 : b0;
#define FX_LD(p) ([&]() { const v2u r_ = *(const v2u*)(p); return (f32x4){bf2f(r_.x & 0xffffu), bf2f(r_.x >> 16), bf2f(r_.y & 0xffffu), bf2f(r_.y >> 16)}; }())
                    g2[it] = FX_LD(p2); v2[it] = FX_LD(p2 + 2816); g1[it] = FX_LD(p1); v1[it] = FX_LD(p1 + 2816); g0[it] = FX_LD(p0); v0[it] = FX_LD(p0 + 2816);
#undef FX_LD
                    m1[it] = (first && !rr) ? 0.f : 1.f; m0[it] = first ? 0.f : 1.f; rowi[it] = valid ? 64 * blk + rr : -1;
                }
#pragma unroll
                for (int it = 0; it < NIT; ++it) {
                    const f32x4 cg = kb_g + k2_g * g2[it] + k1_g * (g1[it] * m1[it]) + k0_g * (g0[it] * m0[it]);
                    const f32x4 cv = kb_v + k2_v * v2[it] + k1_v * (v1[it] * m1[it]) + k0_v * (v0[it] * m0[it]);
                    v2u o; o.x = pk2(pg8::silu_f(cg[0]) * cv[0], pg8::silu_f(cg[1]) * cv[1]); o.y = pk2(pg8::silu_f(cg[2]) * cv[2], pg8::silu_f(cg[3]) * cv[3]);
                    if (rowi[it] >= 0) *(v2u*)(ACT + (size_t)rowi[it] * pg8::ACT_LD + c) = o;
                }
            }
        }
        SEAM(pb + 5);
        if (HAVE(8) && IN(pb + 6)) {
            MK_IDS
            unsigned char* ws = KWS(); unsigned char* wl = ws + WS_W + (size_t)l * W_LAYER;
            pg8::Gemm g{(const bf16*)(ws + WS_R), (const bf16*)(wl + W_DN), M, DMODEL, D_FF, pg8::ACT_LD}; pg8::StaticOrder S; S.init(M, DMODEL, G, bx);
            pg8::EpiResid E{(bf16*)(ws + WS_HB), (float*)(ws + WS_PART), (LAS float*)((LAS unsigned char*)lds + XCH_OFF)};
            pg8::gemm_phase<pg8::EpiResid, pg8::StaticOrder, true, true, true>((LAS unsigned char*)lds, g, S, E, tid);
        }
        SEAM(pb + 6);
    }
    if (HAVE(9) && IN(15)) {
        MK_IDS
        float* out = KOUT(); const float* final_norm = KIN(18); unsigned char* ws = KWS(); const float* PART = (const float*)(ws + WS_PART); const bf16* HB = (const bf16*)(ws + WS_HB);
        const f32x4* gr = (const f32x4*)final_norm + lane; const f32x4 g0 = gr[0], g1 = gr[64], g2 = gr[128], g3 = gr[192];
        for (int m0 = gw; m0 < M; m0 += 4 * NGW) {
            v2u r[4][4]; f32x4 pp[4];
#pragma unroll
            for (int k = 0; k < 4; ++k) { const int m = (m0 + k * NGW < M) ? m0 + k * NGW : m0; const v2u* hr = (const v2u*)(HB + (size_t)m * DMODEL) + lane;
#pragma unroll
                for (int j = 0; j < 4; ++j) r[k][j] = hr[64 * j];
                pp[k] = *(const f32x4*)(PART + (size_t)m * 4); }
#pragma unroll
            for (int k = 0; k < 4; ++k) { const int m = m0 + k * NGW; if (m < M) {
                const float rs = pg8::rs_of(pp[k]); f32x4* xr = (f32x4*)(out + (size_t)m * DMODEL) + lane;
#pragma unroll
                for (int j = 0; j < 4; ++j) { const v2u q = r[k][j]; const f32x4 w = {bf2f(q.x & 0xffffu), bf2f(q.x >> 16), bf2f(q.y & 0xffffu), bf2f(q.y >> 16)}; const f32x4 g = j == 0 ? g0 : j == 1 ? g1 : j == 2 ? g2 : g3; xr[64 * j] = w * rs * g; }
            } }
        }
    }
#if MK_TS >= 0
    {
        __syncthreads();
        if (wave_s == 0 && blockIdx.x == 0 && __builtin_amdgcn_mbcnt_hi(~0u, __builtin_amdgcn_mbcnt_lo(~0u, 0u)) == 0) {
            unsigned long long* ts = (unsigned long long*)(KWS() + 65536); ts[16] = __builtin_amdgcn_s_memrealtime();
            unsigned long long span;
            if (MK_TS == 0) span = ts[1] - ts[0];
            else if (MK_TS <= 7) span = (ts[1 + MK_TS] - ts[MK_TS]) + (ts[8 + MK_TS] - ts[7 + MK_TS]);
            else if (MK_TS == 8) span = ts[16] - ts[15];
            else if (MK_TS == 21) span = 100ull * 1000ull * (ts[32 + 6] - ts[32 + 5]) / (ts[6] - ts[5]) / 100ull;
            else if (MK_TS == 20 || MK_TS == 22 || MK_TS == 23) { const unsigned long long* pw = (const unsigned long long*)(KWS() + WS_PARK + (size_t)16384 * 256 * 4); span = (pw[0] + pw[1] + pw[2] + pw[3]) / 10; }
            else span = ts[16] - ts[0];
            KOUT()[0] = ((float)span * 0.01f - (float)(MK_TSOFF)) * (MK_TS == 9 ? 0.01f : 0.1f);
        }
    }
#endif
#undef IN
#undef SEAM
}

#ifndef MK_LAST
#define MK_LAST NPH
#endif
#ifndef MK_SPLIT
#define MK_SPLIT 0
#endif
extern "C" void kernel_launch(void* const* d_in, const int* in_sizes, int n_in, void* d_out, int out_size, void* d_ws, size_t ws_size, hipStream_t stream) {
    static int grid = 0;
    if (grid == 0) {
        if (n_in != 19 || in_sizes[0] != M * DMODEL || out_size != M * DMODEL || ws_size < WS_TOTAL) {
            fprintf(stderr, "kernel_launch: unexpected shapes: n_in %d in0 %d out %d ws %zu (need %zu); nothing launched\n", n_in, n_in > 0 ? in_sizes[0] : -1, out_size, ws_size, (size_t)WS_END); grid = -1; return; }
        int dev = 0, cus = 0, per_cu = 0;
        if (hipGetDevice(&dev) != hipSuccess || hipDeviceGetAttribute(&cus, hipDeviceAttributeMultiprocessorCount, dev) != hipSuccess) { grid = -1; return; }
        if (hipFuncSetAttribute((const void*)mk_fwd, hipFuncAttributeMaxDynamicSharedMemorySize, LDS_BYTES) != hipSuccess) { fprintf(stderr, "kernel_launch: hipFuncSetAttribute failed\n"); grid = -1; return; }
        if (hipOccupancyMaxActiveBlocksPerMultiprocessor(&per_cu, (const void*)mk_fwd, 512, LDS_BYTES) != hipSuccess || per_cu < 1) { fprintf(stderr, "kernel_launch: occupancy query gives %d\n", per_cu); per_cu = 1; }
        (void)hipGetLastError();
        grid = cus;
        fprintf(stderr, "kernel_launch: cus %d per_cu %d grid %d ws %zu\n", cus, per_cu, grid, ws_size);
    }
    if (grid < 0) return;
    if (hipMemsetAsync((char*)d_ws + WS_CTL, 0, 65536, stream) != hipSuccess) { fprintf(stderr, "kernel_launch: hipMemsetAsync of the barrier words failed; nothing launched\n"); return; }
    Args a{};
    for (int i = 0; i < 19; ++i) a.in[i] = d_in[i];
    a.out = (float*)d_out; a.ws = (unsigned char*)d_ws;
#if MK_SPLIT
    for (int p = 0; p < NPH; ++p) { a.ph_lo = p; a.ph_hi = p + 1; void* args[] = {&a};
        hipError_t e = hipLaunchCooperativeKernel((const void*)mk_fwd, dim3(grid), dim3(512), args, LDS_BYTES, stream);
        if (e != hipSuccess) { fprintf(stderr, "launch %d failed: %s\n", p, hipGetErrorString(e)); break; } }
#else
    a.ph_lo = 0; a.ph_hi = MK_LAST; void* args[] = {&a};
    hipError_t e = hipLaunchCooperativeKernel((const void*)mk_fwd, dim3(grid), dim3(512), args, LDS_BYTES, stream);
    if (e != hipSuccess) fprintf(stderr, "cooperative launch failed: %s (grid %d)\n", hipGetErrorString(e), grid);
#endif
}
```

```cpp
#include <hip/hip_runtime.h>
#include <hip/hip_cooperative_groups.h>
#include <cstdio>
#include <cstdint>
#ifndef MK_TS
#define MK_TS -1
#endif
namespace pg8 {
#define PG8_LAS __attribute__((address_space(3)))
typedef unsigned short bf16_t;
typedef short bf16x8 __attribute__((ext_vector_type(8)));
typedef float f32x4 __attribute__((ext_vector_type(4)));
typedef unsigned u32x4 __attribute__((ext_vector_type(4)));
constexpr int BM = 256, BK = 64, HALF = 128, HTB = HALF * BK * 2  , STAGE_BYTES = 8 * HTB, NXCD = 8, WGM = 4;

__host__ __device__ __forceinline__ int lds_byte(int r, int c) { const int st = (r >> 4) * 2 + (c >> 5), rr = r & 15, cc = c & 31, ob = rr * 64 + cc * 2; return st * 1024 + (ob ^ (((ob >> 9) & 1) << 5)); }
__host__ __device__ __forceinline__ void stage_rc(int b, int& R, int& C) { const int st = b / 1024, sb = b % 1024, swz = sb ^ (((sb >> 9) & 1) << 5); R = (st >> 1) * 16 + swz / 64; C = (st & 1) * 32 + (swz % 64) / 2; }
__host__ __device__ __forceinline__ int perm32(int rho) { const int n = rho >> 4, i = rho & 15; return 8 * (i >> 2) + 4 * n + (i & 3); }

struct Unit { int pm, pn; };
struct Gemm { const bf16_t* A; const bf16_t* Bt; int M, N, K, ld; };
constexpr int ACT_LD = 2816 + 64;

struct StaticOrder {
    int nM, nN, nwg, G, c;
    __host__ __device__ void init(int M, int N, int G_, int c_) { nM = M / BM; nN = N / BM; nwg = nM * nN; G = G_; c = c_; }
    __host__ __device__ bool next(int i, Unit& u) const {
        const long L = (long)i * G + c; if (L >= nwg) return false;
        int wgid = (int)L; { const int q = nwg / NXCD, r = nwg % NXCD, xcd = wgid % NXCD, off = wgid / NXCD; wgid = (xcd < r ? xcd * (q + 1) : r * (q + 1) + (xcd - r) * q) + off; }
        const int nig = WGM * nN, gid = wgid / nig, fm = gid * WGM, gsz = (nM - fm) < WGM ? (nM - fm) : WGM;
        u.pm = fm + ((wgid % nig) % gsz); u.pn = (wgid % nig) / gsz; return true;
    }
    __device__ __forceinline__ void a_ready(const Unit&) const {}
    __device__ __forceinline__ void done(const Unit&) const {}
};

typedef float f32x2 __attribute__((ext_vector_type(2)));
typedef __bf16 bf16x2_t __attribute__((ext_vector_type(2)));
__device__ __forceinline__ unsigned cvt_pk_bf16(float lo, float hi) { f32x2 v = {lo, hi}; bf16x2_t b = __builtin_convertvector(v, bf16x2_t); return __builtin_bit_cast(unsigned, b); }
typedef unsigned u32x2 __attribute__((ext_vector_type(2)));
__device__ __forceinline__ u32x2 pack4(f32x4 v) { u32x2 w; w.x = cvt_pk_bf16(v[0], v[1]); w.y = cvt_pk_bf16(v[2], v[3]); return w; }
__device__ __forceinline__ u32x4 pack8(f32x4 v0, f32x4 v1) { u32x4 w; w.x = cvt_pk_bf16(v0[0], v0[1]); w.y = cvt_pk_bf16(v0[2], v0[3]); w.z = cvt_pk_bf16(v1[0], v1[1]); w.w = cvt_pk_bf16(v1[2], v1[3]); return w; }
__device__ __forceinline__ float gelu_tanh(float x) {
    const float u = x * (1.0f + 0.044715f * x * x);
    const float e = __builtin_amdgcn_exp2f(u * (-2.0f * 0.7978845608028654f * 1.4426950408889634f));
    return x * __builtin_amdgcn_rcpf(1.0f + e);
}
__device__ __forceinline__ f32x2 gelu_tanh2(f32x2 x) {
    const f32x2 u = x * (x * x * 0.044715f + 1.0f);
    const f32x2 a = u * (-2.0f * 0.7978845608028654f * 1.4426950408889634f);
    f32x2 e; e.x = __builtin_amdgcn_exp2f(a.x); e.y = __builtin_amdgcn_exp2f(a.y);
    const f32x2 d = e + 1.0f; f32x2 r; r.x = __builtin_amdgcn_rcpf(d.x); r.y = __builtin_amdgcn_rcpf(d.y);
    return x * r;
}
__device__ __forceinline__ float silu_f(float x) { return x * __builtin_amdgcn_rcpf(1.0f + __builtin_amdgcn_exp2f(x * -1.4426950408889634f)); }
__device__ __forceinline__ float rs_of(const f32x4 p) { return __builtin_amdgcn_rsqf(((p[0] + p[1]) + (p[2] + p[3])) * (1.0f / 1024.0f) + 1e-6f); }
__device__ __forceinline__ float row_rs(const float* part, int row) { return rs_of(*(const f32x4*)(part + (size_t)row * 4)); }

constexpr int PF_PART = 131072 + 4096, PF_COEF = 131072 + 8192, PF_COS = 131072 + 8192;
__device__ __forceinline__ void prefetch_part(const float* part, int pm, int wid, PG8_LAS unsigned char* lds) {
    int z_; asm volatile("s_mov_b32 %0, 0" : "=s"(z_)); const int l_ = __builtin_amdgcn_mbcnt_hi(~0u, __builtin_amdgcn_mbcnt_lo(~0u, (unsigned)z_)); const int w4 = wid & 3;
    __builtin_amdgcn_global_load_lds((const unsigned*)(part + (size_t)(pm * BM + 64 * w4 + l_) * 4), (PG8_LAS unsigned*)(lds + PF_PART + w4 * 1024), 16, 0, 0);
}

struct EpiInProj {
    static constexpr bool PERM = true, AFTER_DRAIN = false; static constexpr bool PREF = true; static constexpr int NPF = 2;
    const float* part; const float* cs; const float* sn; bf16_t* R; float qscale; size_t seg_stride;
    PG8_LAS unsigned char* ldsb;
    __device__ __forceinline__ void prefetch(const Unit& u, int wid, PG8_LAS unsigned char* lds) const {
        int z_; asm volatile("s_mov_b32 %0, 0" : "=s"(z_)); const int l_ = __builtin_amdgcn_mbcnt_hi(~0u, __builtin_amdgcn_mbcnt_lo(~0u, (unsigned)z_));
#pragma unroll
        for (int i = 0; i < 2; ++i) { const int sl = 2 * wid + i, q = sl & 3, kind = sl >> 2;
            const float* tab = (kind == 1) ? cs : sn;
            const float* src = (kind == 0 || kind == 3) ? part + (size_t)(u.pm * BM + 64 * q + l_) * 4 : tab + (size_t)(u.pm * BM + 32 * q + (l_ >> 1)) * 8 + (l_ & 1) * 4;
            const int dst = (kind == 0 || kind == 3) ? PF_PART + q * 1024 : PF_COS + (kind - 1) * 4096 + q * 1024;
            __builtin_amdgcn_global_load_lds((const unsigned*)src, (PG8_LAS unsigned*)(lds + dst), 16, 0, 0); }
    }
    __device__ __forceinline__ void operator()(const f32x4 (&acc)[2][2][4][2], const Unit& u, int wr, int wc, int fr_in, int fq_in) const {
        int z_; asm volatile("s_mov_b32 %0, 0" : "=s"(z_)); const int l_ = __builtin_amdgcn_mbcnt_hi(~0u, __builtin_amdgcn_mbcnt_lo(~0u, (unsigned)z_)); const int fr = l_ & 15, fq = l_ >> 4; (void)fr_in; (void)fq_in;
        const int t = u.pn >> 1;
        bf16_t* O = R + (size_t)t * seg_stride;
        const int colt = (u.pn & 1) * 256 + wc * 32 + 8 * fq;
        const bool isrope = (t == 2 || t == 3);
        const bool roper = isrope && ((wc & 1) == 0) && (fq < 2);
        const float qs = (t == 2) ? qscale : 1.0f;
        const int row0 = u.pm * BM + wr * 64 + 4 * fr;
        f32x4 pr[2][4];
#pragma unroll
        for (int ai = 0; ai < 2; ++ai)
#pragma unroll
            for (int m = 0; m < 4; ++m) pr[ai][m] = *(const PG8_LAS f32x4*)(ldsb + PF_PART + (ai * HALF + wr * 64 + 4 * fr + m) * 16);
        float rsv[2][4];
#pragma unroll
        for (int ai = 0; ai < 2; ++ai)
#pragma unroll
            for (int m = 0; m < 4; ++m) rsv[ai][m] = rs_of(pr[ai][m]);
        asm volatile("" : "+v"(rsv[0][0]), "+v"(rsv[0][1]), "+v"(rsv[0][2]), "+v"(rsv[0][3]), "+v"(rsv[1][0]), "+v"(rsv[1][1]), "+v"(rsv[1][2]), "+v"(rsv[1][3]));
        if (t < 2) {
#pragma unroll
            for (int ai = 0; ai < 2; ++ai)
#pragma unroll
                for (int m = 0; m < 4; ++m) { const float rs = rsv[ai][m]; bf16_t* rowp = O + (size_t)(row0 + ai * HALF + m) * 512 + colt;
#pragma unroll
                    for (int bj = 0; bj < 2; ++bj) { f32x4 v0 = acc[ai][bj][m][0] * rs, v1 = acc[ai][bj][m][1] * rs;
#pragma unroll
                        for (int j = 0; j < 4; j += 2) { const f32x2 g0 = gelu_tanh2((f32x2){v0[j], v0[j + 1]}), g1 = gelu_tanh2((f32x2){v1[j], v1[j + 1]}); v0[j] = g0.x; v0[j + 1] = g0.y; v1[j] = g1.x; v1[j + 1] = g1.y; }
                        *(u32x4*)(rowp + bj * HALF) = pack8(v0, v1); } }
        } else if (isrope) {
            f32x4 cvv[4], svv[4];
#pragma unroll
            for (int m = 0; m < 4; ++m) { const size_t ro = (size_t)(row0 + HALF + m) * 8 + 4 * (fq & 1); cvv[m] = *(const f32x4*)(cs + ro); svv[m] = *(const f32x4*)(sn + ro); }
#pragma unroll
            for (int ai = 0; ai < 2; ++ai) {
#pragma unroll
                for (int m = 0; m < 4; ++m) { const float rs = rsv[ai][m] * qs; bf16_t* rowp = O + (size_t)(row0 + ai * HALF + m) * 512 + colt;
                    f32x4 cv, sv;
                    if (ai == 0) { const PG8_LAS unsigned char* cp_ = ldsb + PF_COS + (wr * 64 + 4 * fr + m) * 32 + (fq & 1) * 16; cv = *(const PG8_LAS f32x4*)cp_; sv = *(const PG8_LAS f32x4*)(cp_ + 4096); }
                    else { cv = cvv[m]; sv = svv[m]; asm volatile("" : "+v"(cv), "+v"(sv)); }
#pragma unroll
                    for (int bj = 0; bj < 2; ++bj) { f32x4 v0 = acc[ai][bj][m][0] * rs, v1 = acc[ai][bj][m][1] * rs;
                        if (roper) {
                            const float a0 = v0[0], b0 = v0[1], a1 = v0[2], b1 = v0[3], a2 = v1[0], b2 = v1[1], a3 = v1[2], b3 = v1[3];
                            v0[0] = a0 * cv[0] - b0 * sv[0]; v0[1] = b0 * cv[0] + a0 * sv[0];
                            v0[2] = a1 * cv[1] - b1 * sv[1]; v0[3] = b1 * cv[1] + a1 * sv[1];
                            v1[0] = a2 * cv[2] - b2 * sv[2]; v1[1] = b2 * cv[2] + a2 * sv[2];
                            v1[2] = a3 * cv[3] - b3 * sv[3]; v1[3] = b3 * cv[3] + a3 * sv[3];
                        }
                        *(u32x4*)(rowp + bj * HALF) = pack8(v0, v1); } }
                asm volatile("" ::: "memory");
            }
        } else {
#pragma unroll
            for (int ai = 0; ai < 2; ++ai)
#pragma unroll
                for (int m = 0; m < 4; ++m) { const float rs = rsv[ai][m]; bf16_t* rowp = O + (size_t)(row0 + ai * HALF + m) * 512 + colt;
#pragma unroll
                    for (int bj = 0; bj < 2; ++bj) *(u32x4*)(rowp + bj * HALF) = pack8(acc[ai][bj][m][0] * rs, acc[ai][bj][m][1] * rs); }
        }
    }
};

struct EpiResid {
    static constexpr bool PERM = true, AFTER_DRAIN = false; static constexpr bool PREF = false; static constexpr int NPF = 0;
    bf16_t* H; float* part; PG8_LAS float* xch;
    __device__ __forceinline__ void operator()(const f32x4 (&acc)[2][2][4][2], const Unit& u, int wr, int wc, int fr_in, int fq_in) const {
        int z_; asm volatile("s_mov_b32 %0, 0" : "=s"(z_)); const int l_ = __builtin_amdgcn_mbcnt_hi(~0u, __builtin_amdgcn_mbcnt_lo(~0u, (unsigned)z_)); const int fr = l_ & 15, fq = l_ >> 4; (void)fr_in; (void)fq_in;
        const int col0 = u.pn * BM + wc * 32 + 8 * fq;
        u32x4 raw[2][4][2];
#pragma unroll
        for (int ai = 0; ai < 2; ++ai)
#pragma unroll
            for (int m = 0; m < 4; ++m) { const bf16_t* hp = H + (size_t)(u.pm * BM + ai * HALF + wr * 64 + 4 * fr + m) * 1024 + col0;
                raw[ai][m][0] = *(const u32x4*)hp; raw[ai][m][1] = *(const u32x4*)(hp + HALF); }
        asm volatile("" ::: "memory");
#pragma unroll
        for (int ai = 0; ai < 2; ++ai)
#pragma unroll
            for (int m = 0; m < 4; ++m) {
                const int row = u.pm * BM + ai * HALF + wr * 64 + 4 * fr + m;
                bf16_t* hp = H + (size_t)row * 1024 + col0;
                float ss = 0.f;
#pragma unroll
                for (int bj = 0; bj < 2; ++bj) {
                    const u32x4 rw = raw[ai][m][bj];
                    f32x4 h0, h1;
                    h0[0] = __uint_as_float(rw.x << 16); h0[1] = __uint_as_float(rw.x & 0xffff0000u); h0[2] = __uint_as_float(rw.y << 16); h0[3] = __uint_as_float(rw.y & 0xffff0000u);
                    h1[0] = __uint_as_float(rw.z << 16); h1[1] = __uint_as_float(rw.z & 0xffff0000u); h1[2] = __uint_as_float(rw.w << 16); h1[3] = __uint_as_float(rw.w & 0xffff0000u);
                    h0 = h0 + acc[ai][bj][m][0]; h1 = h1 + acc[ai][bj][m][1];
                    ss += ((h0[0] * h0[0] + h0[1] * h0[1]) + (h0[2] * h0[2] + h0[3] * h0[3])) + ((h1[0] * h1[0] + h1[1] * h1[1]) + (h1[2] * h1[2] + h1[3] * h1[3]));
                    *(u32x4*)(hp + bj * HALF) = pack8(h0, h1);
                }
                ss += __int_as_float(__builtin_amdgcn_ds_bpermute(4 * ((fq * 16 + fr) ^ 16), __float_as_int(ss))); ss += __int_as_float(__builtin_amdgcn_ds_bpermute(4 * ((fq * 16 + fr) ^ 32), __float_as_int(ss)));
                if (fq == 0) xch[(wr * 4 + wc) * 128 + ai * 64 + 4 * fr + m] = ss;
            }
        asm volatile("s_waitcnt lgkmcnt(0)\n\ts_barrier" ::: "memory");
        if (wc == 0) {
#pragma unroll
            for (int k = 0; k < 2; ++k) { const int r = l_ + 64 * k;
                const float s = (xch[(wr * 4 + 0) * 128 + r] + xch[(wr * 4 + 1) * 128 + r]) + (xch[(wr * 4 + 2) * 128 + r] + xch[(wr * 4 + 3) * 128 + r]);
                const int row = u.pm * BM + (r >> 6) * HALF + wr * 64 + (r & 63);
                part[(size_t)row * 4 + u.pn] = s; }
        }
        asm volatile("s_waitcnt lgkmcnt(0)\n\ts_barrier" ::: "memory");
    }
};

struct EpiUp {
    static constexpr bool PERM = true, AFTER_DRAIN = false; static constexpr bool PREF = true; static constexpr int NPF = 1;
    const float* part; const float* cw; const float* cb; bf16_t* act; bf16_t* top; bf16_t* bot;
    PG8_LAS unsigned char* ldsb;
    __device__ __forceinline__ void prefetch(const Unit& u, int wid, PG8_LAS unsigned char* lds) const {
        if (wid < 4) { prefetch_part(part, u.pm, wid, lds); return; }
        int z_; asm volatile("s_mov_b32 %0, 0" : "=s"(z_)); const int l_ = __builtin_amdgcn_mbcnt_hi(~0u, __builtin_amdgcn_mbcnt_lo(~0u, (unsigned)z_)); const int j = wid - 4;
        const float* src = (j < 3 ? cw + (size_t)j * 5632 : cb) + (l_ >> 5) * 2816 + u.pn * 128 + (l_ & 31) * 4;
        __builtin_amdgcn_global_load_lds((const unsigned*)src, (PG8_LAS unsigned*)(lds + PF_COEF + j * 1024), 16, 0, 0);
    }
    __device__ __forceinline__ void operator()(f32x4 (&acc)[2][2][4][2], const Unit& u, int wr, int wc, int fr_in, int fq_in) const {
        int z_; asm volatile("s_mov_b32 %0, 0" : "=s"(z_)); const int l_ = __builtin_amdgcn_mbcnt_hi(~0u, __builtin_amdgcn_mbcnt_lo(~0u, (unsigned)z_)); const int fr = l_ & 15, fq = l_ >> 4; (void)fr_in; (void)fq_in;
        const int cbase = u.pn * 128 + wc * 32 + 8 * fq;
        f32x4 kg[2][4], kv[2][4];
#define UP_COEF(n) do { const PG8_LAS unsigned char* cp_ = ldsb + PF_COEF + (wc * 32 + 8 * fq + 4 * (n)) * 4;     \
        _Pragma("unroll") for (int j_ = 0; j_ < 4; ++j_) { kg[n][j_] = *(const PG8_LAS f32x4*)(cp_ + j_ * 1024); kv[n][j_] = *(const PG8_LAS f32x4*)(cp_ + j_ * 1024 + 512); } } while (0)
        {
            const PG8_LAS f32x4* pp = (const PG8_LAS f32x4*)(ldsb + PF_PART + (wr * 64 + 4 * fr) * 16);
            f32x4 pr[2][4];
#pragma unroll
            for (int ai = 0; ai < 2; ++ai)
#pragma unroll
                for (int m = 0; m < 4; ++m) pr[ai][m] = pp[(size_t)(ai * HALF + m)];
            UP_COEF(0);
#pragma unroll
            for (int ai = 0; ai < 2; ++ai)
#pragma unroll
                for (int m = 0; m < 4; ++m) { const float rs = rs_of(pr[ai][m]);
#pragma unroll
                    for (int bj = 0; bj < 2; ++bj)
#pragma unroll
                        for (int n = 0; n < 2; ++n) acc[ai][bj][m][n] = acc[ai][bj][m][n] * rs; }
        }
        asm volatile("" ::: "memory");
        UP_COEF(1);
#undef UP_COEF
        asm volatile("" ::: "memory");
        { int z2_; asm volatile("s_mov_b32 %0, 0" : "=s"(z2_)); const int l2_ = __builtin_amdgcn_mbcnt_hi(~0u, __builtin_amdgcn_mbcnt_lo(~0u, (unsigned)z2_)); const int fr = l2_ & 15, cbase = u.pn * 128 + wc * 32 + 8 * (l2_ >> 4);
#pragma unroll
        for (int ai = 0; ai < 2; ++ai) { const int blk = (u.pm * BM + ai * HALF + wr * 64) >> 6;
#pragma unroll
            for (int n = 0; n < 2; ++n) { const int ch = cbase + 4 * n;
                if (fr == 0) { bf16_t* tp = top + (size_t)(blk * 2) * 5632 + ch; *(u32x2*)tp = pack4(acc[ai][0][0][n]); *(u32x2*)(tp + 2816) = pack4(acc[ai][1][0][n]); *(u32x2*)(tp + 5632) = pack4(acc[ai][0][1][n]); *(u32x2*)(tp + 5632 + 2816) = pack4(acc[ai][1][1][n]); }
                if (fr == 15) { bf16_t* bp = bot + (size_t)(blk * 2) * 5632 + ch; *(u32x2*)bp = pack4(acc[ai][0][2][n]); *(u32x2*)(bp + 2816) = pack4(acc[ai][1][2][n]); *(u32x2*)(bp + 5632) = pack4(acc[ai][0][3][n]); *(u32x2*)(bp + 5632 + 2816) = pack4(acc[ai][1][3][n]); } } } }
#define UP_SHR0(srcv) __int_as_float(__builtin_amdgcn_update_dpp(0, __float_as_int(srcv), 0x111, 0xf, 0xf, true))
        {
#pragma unroll
            for (int n = 0; n < 2; ++n)
#pragma unroll
                for (int jp = 0; jp < 2; ++jp) {
                    const int j0 = 2 * jp, j1 = 2 * jp + 1;
                    const f32x2 G0 = {kg[n][0][j0], kg[n][0][j1]}, G1 = {kg[n][1][j0], kg[n][1][j1]}, G2 = {kg[n][2][j0], kg[n][2][j1]}, GB = {kg[n][3][j0], kg[n][3][j1]};
                    const f32x2 V0 = {kv[n][0][j0], kv[n][0][j1]}, V1 = {kv[n][1][j0], kv[n][1][j1]}, V2 = {kv[n][2][j0], kv[n][2][j1]}, VB = {kv[n][3][j0], kv[n][3][j1]};
#pragma unroll
                    for (int ai = 0; ai < 2; ++ai) {
                        f32x2 xg[4], xv[4];
#pragma unroll
                        for (int m = 0; m < 4; ++m) { xg[m] = (f32x2){acc[ai][0][m][n][j0], acc[ai][0][m][n][j1]}; xv[m] = (f32x2){acc[ai][1][m][n][j0], acc[ai][1][m][n][j1]}; }
                        f32x2 dg3, dg2, dv3, dv2;
                        dg3.x = UP_SHR0(xg[3].x); dg3.y = UP_SHR0(xg[3].y); dg2.x = UP_SHR0(xg[2].x); dg2.y = UP_SHR0(xg[2].y);
                        dv3.x = UP_SHR0(xv[3].x); dv3.y = UP_SHR0(xv[3].y); dv2.x = UP_SHR0(xv[2].x); dv2.y = UP_SHR0(xv[2].y);
#pragma unroll
                        for (int m = 3; m >= 0; --m) {
                            const f32x2 g1 = m >= 1 ? xg[m >= 1 ? m - 1 : 0] : dg3, g2 = m >= 2 ? xg[m >= 2 ? m - 2 : 0] : (m == 1 ? dg3 : dg2);
                            const f32x2 v1 = m >= 1 ? xv[m >= 1 ? m - 1 : 0] : dv3, v2 = m >= 2 ? xv[m >= 2 ? m - 2 : 0] : (m == 1 ? dv3 : dv2);
                            const f32x2 cg = GB + G2 * xg[m] + G1 * g1 + G0 * g2;
                            const f32x2 cv = VB + V2 * xv[m] + V1 * v1 + V0 * v2;
                            const f32x2 ea = cg * -1.4426950408889634f; f32x2 ee; ee.x = __builtin_amdgcn_exp2f(ea.x); ee.y = __builtin_amdgcn_exp2f(ea.y);
                            const f32x2 dd = ee + 1.0f; f32x2 rr; rr.x = __builtin_amdgcn_rcpf(dd.x); rr.y = __builtin_amdgcn_rcpf(dd.y);
                            const f32x2 oo = (cg * rr) * cv; float o0 = oo.x, o1 = oo.y;
                            asm volatile("" : "+v"(o0), "+v"(o1));
                            acc[ai][0][m][n][j0] = o0; acc[ai][0][m][n][j1] = o1;
                        }
                    }
                }
        }
#undef UP_SHR0
        asm volatile("" ::: "memory");
        { int z4_; asm volatile("s_mov_b32 %0, 0" : "=s"(z4_)); const int l4_ = __builtin_amdgcn_mbcnt_hi(~0u, __builtin_amdgcn_mbcnt_lo(~0u, (unsigned)z4_)); const int fr = l4_ & 15, cbase = u.pn * 128 + wc * 32 + 8 * (l4_ >> 4);
#pragma unroll
        for (int ai = 0; ai < 2; ++ai)
#pragma unroll
            for (int m = 0; m < 4; ++m) { const int row = u.pm * BM + ai * HALF + wr * 64 + 4 * fr + m;
                if (!(m < 2 && fr == 0)) *(u32x4*)(act + (size_t)row * ACT_LD + cbase) = pack8(acc[ai][0][m][0], acc[ai][0][m][1]); } }
    }
};

template <class Epi, class Sched, bool ALIGN_EPI = false, bool SP2 = false, bool VW = false>
__device__ __forceinline__ void gemm_phase(PG8_LAS unsigned char* lds, const Gemm g, const Sched& S, const Epi& E, const int tid) {
    const int wid = __builtin_amdgcn_readfirstlane(tid >> 6), lane = tid & 63, wr = wid >> 2, wc = wid & 3, fr = lane & 15, fq = lane >> 4;
    const int K = g.ld, nt = g.K / BK;
    unsigned voffA[2], voffB[2];
#pragma unroll
    for (int i = 0; i < 2; ++i) { int R, C; stage_rc(tid * 16 + i * 8192, R, C); const int Rb = Epi::PERM ? ((R & ~31) + perm32(R & 31)) : R;
        const int Ra = (R & ~63) + 4 * (R & 15) + ((R >> 4) & 3);
        voffA[i] = (unsigned)(Ra * K + C) * 2u; voffB[i] = (unsigned)(Rb * K + C) * 2u; }
    const size_t kstep = (size_t)(BK * 2);
    const size_t hstep = (size_t)HALF * K * 2;
    const size_t tstep = 2 * hstep;
    const unsigned ldsw = (unsigned)wid * 1024u;
    const int aoff = lds_byte(wr * 64 + fr, fq * 8), boff = lds_byte(wc * 32 + fr, fq * 8);
#define PG8_SA(b, h) (((b) * 2 + (h)) * HTB)
#define PG8_SB(b, h) ((4 + (b) * 2 + (h)) * HTB)
#define PG8_STAGE(bufoff, gbase, voff) do { _Pragma("unroll") for (int _i = 0; _i < 2; ++_i) \
        __builtin_amdgcn_global_load_lds((const unsigned*)((const char*)(gbase) + (voff)[_i]), (PG8_LAS unsigned*)(lds + (bufoff) + ldsw + _i * 8192), 16, 0, 0); } while (0)
#define PG8_LDA(dst, b, h) do { _Pragma("unroll") for (int m = 0; m < 4; ++m) _Pragma("unroll") for (int k = 0; k < 2; ++k) dst[m][k] = *(const PG8_LAS bf16x8*)(lds + PG8_SA(b, h) + aoff + m * 2048 + k * 1024); } while (0)
#define PG8_LDB(dst, b, h) do { _Pragma("unroll") for (int n = 0; n < 2; ++n) _Pragma("unroll") for (int k = 0; k < 2; ++k) dst[n][k] = *(const PG8_LAS bf16x8*)(lds + PG8_SB(b, h) + boff + n * 2048 + k * 1024); } while (0)
#define PG8_MMA(ai, bj, At, Bt) do { __builtin_amdgcn_s_setprio(1); _Pragma("unroll") for (int m = 0; m < 4; ++m) _Pragma("unroll") for (int n = 0; n < 2; ++n) _Pragma("unroll") for (int k = 0; k < 2; ++k) \
        acc[ai][bj][m][n] = __builtin_amdgcn_mfma_f32_16x16x32_bf16(Bt[n][k], At[m][k], acc[ai][bj][m][n], 0, 0, 0); __builtin_amdgcn_s_setprio(0); } while (0)
#define PG8_WAIT_V(n) asm volatile("s_waitcnt vmcnt(" #n ")" ::: "memory")
#define PG8_WAIT_L(n) asm volatile("s_waitcnt lgkmcnt(" #n ")" ::: "memory")
#define PG8_BAR __builtin_amdgcn_s_barrier()
#define PG8_SCHED __builtin_amdgcn_sched_barrier(0)
    if constexpr (VW) __builtin_amdgcn_s_waitcnt(0x0F70);
    Unit cur, nxt; int ui = 0;
    if (!S.next(0, cur)) return;
    f32x4 acc[2][2][4][2];
#pragma unroll
    for (int a = 0; a < 2; ++a)
#pragma unroll
        for (int b = 0; b < 2; ++b)
#pragma unroll
            for (int m = 0; m < 4; ++m)
#pragma unroll
                for (int n = 0; n < 2; ++n) acc[a][b][m][n] = (f32x4){0.f, 0.f, 0.f, 0.f};
    bf16x8 At[4][2], B0[2][2], B1[2][2];
    const char* cA = (const char*)g.A + (size_t)cur.pm * tstep; const char* cB = (const char*)g.Bt + (size_t)cur.pn * tstep;
    S.a_ready(cur);
    if constexpr (SP2) {
        PG8_STAGE(PG8_SB(0, 0), cB, voffB); PG8_STAGE(PG8_SB(0, 1), cB + hstep, voffB); PG8_STAGE(PG8_SA(0, 0), cA, voffA); PG8_STAGE(PG8_SA(0, 1), cA + hstep, voffA);
        if (wr == 1) PG8_BAR;
        PG8_WAIT_V(2); PG8_BAR;
        PG8_STAGE(PG8_SB(1, 0), cB + kstep, voffB); PG8_STAGE(PG8_SA(1, 0), cA + kstep, voffA); PG8_STAGE(PG8_SB(1, 1), cB + hstep + kstep, voffB);
        PG8_WAIT_V(6); PG8_BAR;
    } else {
        PG8_STAGE(PG8_SB(0, 0), cB, voffB); PG8_STAGE(PG8_SA(0, 0), cA, voffA); PG8_STAGE(PG8_SB(0, 1), cB + hstep, voffB); PG8_STAGE(PG8_SA(0, 1), cA + hstep, voffA);
        if (wr == 1) PG8_BAR;
        PG8_WAIT_V(4); PG8_BAR;
        PG8_STAGE(PG8_SB(1, 0), cB + kstep, voffB); PG8_STAGE(PG8_SA(1, 0), cA + kstep, voffA); PG8_STAGE(PG8_SB(1, 1), cB + hstep + kstep, voffB);
        PG8_WAIT_V(6); PG8_BAR;
    }
    for (;;) {
        const bool has_next = S.next(ui + 1, nxt);
        const char* nA = has_next ? (const char*)g.A + (size_t)nxt.pm * tstep : cA; const char* nB = has_next ? (const char*)g.Bt + (size_t)nxt.pn * tstep : cB;
        for (int t = 0; t < nt; t += 2) {
            const bool last = (t == nt - 2);
            const char* a1 = cA + (size_t)(t + 1) * kstep;
            const char* a2 = last ? nA : cA + (size_t)(t + 2) * kstep; const char* b2 = last ? nB : cB + (size_t)(t + 2) * kstep;
            const char* a3 = a2 + kstep; const char* b3 = b2 + kstep;
            if (last && has_next) S.a_ready(nxt);
            if constexpr (SP2) {
            if constexpr (Epi::PREF) { if (last) E.prefetch(cur, wid, lds); }
            PG8_LDB(B0, 0, 0); PG8_LDB(B1, 0, 1); PG8_SCHED; PG8_LDA(At, 0, 0); PG8_STAGE(PG8_SA(1, 1), a1 + hstep, voffA);
            if (Epi::PREF && last) { if constexpr (Epi::NPF == 2) PG8_WAIT_V(10); else PG8_WAIT_V(9); } else PG8_WAIT_V(8); PG8_WAIT_L(0); PG8_BAR; PG8_MMA(0, 0, At, B0); PG8_MMA(0, 1, At, B1); PG8_BAR; PG8_SCHED;
            PG8_LDA(At, 0, 1); PG8_STAGE(PG8_SB(0, 0), b2, voffB); PG8_STAGE(PG8_SB(0, 1), b2 + hstep, voffB); PG8_STAGE(PG8_SA(0, 0), a2, voffA);
            if (Epi::PREF && last) { if constexpr (Epi::NPF == 2) PG8_WAIT_V(10); else PG8_WAIT_V(9); } else PG8_WAIT_V(8); PG8_WAIT_L(0); PG8_BAR; PG8_MMA(1, 0, At, B0); PG8_MMA(1, 1, At, B1); PG8_BAR; PG8_SCHED;
            PG8_LDB(B0, 1, 0); PG8_LDB(B1, 1, 1); PG8_SCHED; PG8_LDA(At, 1, 0); PG8_STAGE(PG8_SA(0, 1), a2 + hstep, voffA);
            PG8_WAIT_V(8); PG8_WAIT_L(0); PG8_BAR; PG8_MMA(0, 0, At, B0); PG8_MMA(0, 1, At, B1); PG8_BAR; PG8_SCHED;
            PG8_LDA(At, 1, 1); PG8_STAGE(PG8_SB(1, 0), b3, voffB); PG8_STAGE(PG8_SB(1, 1), b3 + hstep, voffB); PG8_STAGE(PG8_SA(1, 0), a3, voffA);
            PG8_WAIT_V(8); PG8_WAIT_L(0); PG8_BAR; PG8_MMA(1, 0, At, B0); PG8_MMA(1, 1, At, B1); PG8_BAR; PG8_SCHED;
            } else {
            PG8_LDB(B0, 0, 0); PG8_SCHED; PG8_LDA(At, 0, 0); PG8_STAGE(PG8_SA(1, 1), a1 + hstep, voffA);
            PG8_WAIT_L(8); PG8_BAR; PG8_WAIT_L(0); PG8_MMA(0, 0, At, B0); PG8_BAR; PG8_SCHED;
            PG8_LDB(B1, 0, 1); PG8_STAGE(PG8_SB(0, 0), b2, voffB);
            PG8_BAR; PG8_WAIT_L(0); PG8_MMA(0, 1, At, B1); PG8_BAR;
            PG8_LDA(At, 0, 1); PG8_STAGE(PG8_SA(0, 0), a2, voffA);
            PG8_BAR; PG8_WAIT_L(0); PG8_MMA(1, 0, At, B0); PG8_BAR; PG8_SCHED;
            PG8_STAGE(PG8_SB(0, 1), b2 + hstep, voffB);
            PG8_WAIT_V(6); PG8_BAR; PG8_MMA(1, 1, At, B1); PG8_BAR;
            PG8_LDB(B0, 1, 0); PG8_SCHED; PG8_LDA(At, 1, 0); PG8_STAGE(PG8_SA(0, 1), a2 + hstep, voffA);
            PG8_WAIT_L(8); PG8_BAR; PG8_WAIT_L(0); PG8_MMA(0, 0, At, B0); PG8_BAR; PG8_SCHED;
            PG8_LDB(B1, 1, 1); PG8_STAGE(PG8_SB(1, 0), b3, voffB);
            PG8_BAR; PG8_WAIT_L(0); PG8_MMA(0, 1, At, B1); PG8_BAR;
            PG8_LDA(At, 1, 1); PG8_STAGE(PG8_SA(1, 0), a3, voffA);
            PG8_BAR; PG8_WAIT_L(0); PG8_MMA(1, 0, At, B0); PG8_BAR; PG8_SCHED;
            PG8_STAGE(PG8_SB(1, 1), b3 + hstep, voffB);
            PG8_WAIT_V(6); PG8_BAR; PG8_MMA(1, 1, At, B1); PG8_BAR;
            }
        }
        if constexpr (ALIGN_EPI) { if (wr == 0) PG8_BAR; }
        if constexpr (!Epi::AFTER_DRAIN) { E(acc, cur, wr, wc, fr, fq); S.done(cur); }
        if (!has_next) break;
#pragma unroll
        for (int a = 0; a < 2; ++a)
#pragma unroll
            for (int b = 0; b < 2; ++b)
#pragma unroll
                for (int m = 0; m < 4; ++m)
#pragma unroll
                    for (int n = 0; n < 2; ++n) acc[a][b][m][n] = (f32x4){0.f, 0.f, 0.f, 0.f};
        cur = nxt; cA = nA; cB = nB; ++ui;
        if constexpr (ALIGN_EPI) { if (wr == 1) PG8_BAR; }
    }
    PG8_WAIT_V(0);
    if constexpr (!ALIGN_EPI) { if (wr == 0) PG8_BAR; }
    PG8_BAR;
    if constexpr (Epi::AFTER_DRAIN) { E.fused(acc, cur, wr, wc, fr, fq, lds, wid, lane); S.done(cur); }
#undef PG8_SA
#undef PG8_SB
#undef PG8_STAGE
#undef PG8_LDA
#undef PG8_LDB
#undef PG8_MMA
#undef PG8_WAIT_V
#undef PG8_WAIT_L
#undef PG8_BAR
#undef PG8_SCHED
}
}
#include <hip/hip_bf16.h>
#include <cmath>
namespace attn_body {
#if defined(MK_TS) && MK_TS == 20
#define APB0() apt0_ = __builtin_readcyclecounter()
#define APB1() apw_ += __builtin_readcyclecounter() - apt0_
#define APW(N) asm volatile("s_waitcnt vmcnt(" #N ") lgkmcnt(0)":::"memory")
#define ATTN_PROBE_OUT() do{ if(blockIdx.x==0&&tid==0){ A.park[16384*256+0]+=0; ((unsigned long long*)(A.park+16384*256))[mp+2*(qb&1)]=apw_; } }while(0)
#else
#define ATTN_PROBE_OUT() do{}while(0)
#define APB0() do{}while(0)
#define APW(N) do{}while(0)
#define APB1() do{}while(0)
#endif
using bf16=__hip_bfloat16;
using bf16x8=__attribute__((ext_vector_type(8)))short;
using s16x4=__attribute__((ext_vector_type(4)))short;
using f32x16=__attribute__((ext_vector_type(16)))float;
using u32x4=__attribute__((ext_vector_type(4)))unsigned;
constexpr int SEQ=4096,PQ=512,PM=1024;
constexpr int NW=8,QBLK=32,QB=QBLK*NW,KVBLK=64;
__device__ __forceinline__ int crow(int r,int hi){return (r&3)+8*(r>>2)+4*hi;}
#define SBAR() __builtin_amdgcn_sched_barrier(0)
__device__ __forceinline__ void cmask(f32x16&p0,f32x16&p1,int jb,int qrel,int hi){
  asm volatile("":"+v"(hi));
  const float NEG=-INFINITY; int kb=64*jb+4*hi;
  #pragma unroll
  for(int r=0;r<16;++r){int kv=kb+(r&3)+8*(r>>2); if(kv>qrel)p0[r]=NEG; if(kv+32>qrel)p1[r]=NEG;}
}
constexpr int KSLOT=8192,NKS=4,VSLOT=16384,NVS=3;
constexpr int LDS_K=0, LDS_V=NKS*KSLOT, LDS_WS=LDS_V+NVS*VSLOT, LDS_Q=LDS_WS+NW*64*4, LDS_BYTES=LDS_Q+NW*4096;
__device__ __forceinline__ void glds16(const void*sbase,unsigned voff,unsigned lds_dst){unsigned keep;
  asm volatile("s_mov_b32 %0, m0\n\ts_mov_b32 m0, %3\n\ts_nop 3\n\tglobal_load_lds_dwordx4 %1, %2\n\ts_mov_b32 m0, %0":"=&s"(keep):"v"(voff),"s"(sbase),"s"(lds_dst):"memory");}
typedef float f32x2_t __attribute__((ext_vector_type(2))); typedef __bf16 bf16x2_t __attribute__((ext_vector_type(2)));
__device__ __forceinline__ unsigned cvtpk_s(float lo,float hi){f32x2_t v={lo,hi};bf16x2_t b=__builtin_convertvector(v,bf16x2_t);return __builtin_bit_cast(unsigned,b);}
#define WAIT_BAR(N) asm volatile("s_waitcnt vmcnt(" #N ") lgkmcnt(0)\n\ts_barrier":::"memory")
typedef __attribute__((address_space(3))) const char* lds_cptr;
typedef short v4i16_t __attribute__((ext_vector_type(4)));
__device__ __forceinline__ bf16x8 kld(lds_cptr kp,int i){ return *(const __attribute__((address_space(3))) bf16x8*)(kp+(i>>1)*2048+(i&1)*512); }
__device__ __forceinline__ s16x4 vtr(lds_cptr p){ return __builtin_bit_cast(s16x4,__builtin_amdgcn_ds_read_tr16_b64_v4i16((__attribute__((address_space(3))) v4i16_t*)p)); }
#define MX3(a,b,c) __builtin_fmaxf(__builtin_fmaxf((a),(b)),(c))
__device__ __forceinline__ float rowmax(const f32x16&p0,const f32x16&p1){
  float a=MX3(p0[0],p0[1],p1[0]),b=MX3(p0[2],p0[3],p1[1]);a=MX3(a,p1[2],p1[3]);
  #pragma unroll
  for(int r=4;r<16;r+=4){a=MX3(a,p0[r],p0[r+1]);b=MX3(b,p0[r+2],p0[r+3]);a=MX3(a,p1[r],p1[r+1]);b=MX3(b,p1[r+2],p1[r+3]);}
  float m=__builtin_fmaxf(a,b);
  auto rr=__builtin_amdgcn_permlane32_swap(__float_as_uint(m),__float_as_uint(m),false,false);
  return __builtin_fmaxf(__uint_as_float(rr[0]),__uint_as_float(rr[1]));
}
#define MFMA32(a,b,c) __builtin_amdgcn_mfma_f32_32x32x16_bf16(a,b,c,0,0,0)
__device__ __forceinline__ int fresh_lane(){ int z_; asm volatile("s_mov_b32 %0, 0":"=s"(z_)); return __builtin_amdgcn_mbcnt_hi(~0u,__builtin_amdgcn_mbcnt_lo(~0u,(unsigned)z_)); }
#define QL(d0) (*(const __attribute__((address_space(3))) bf16x8*)(qp0+(d0)*1024))
struct AttnArgs { const bf16* Q; const bf16* K; const bf16* V; bf16* MIX; const float* subln; unsigned* park; float lam; float post; };

template<int THRL> __device__ __forceinline__ void attn_unit(const int tid,const int b,const int h,const int qb,const AttnArgs&A,char*shm){
  const int lane=tid&63,r32=lane&31,hi=lane>>5; const int wid=__builtin_amdgcn_readfirstlane(tid>>6);
  const long rowbase=(long)b*SEQ; const int q0=qb*QB;
  const unsigned lds0=(unsigned)(uintptr_t)shm;
  const unsigned koff=(unsigned)(lane*PQ+wid*8)*2u;
  const unsigned voff=(unsigned)((16*(wid&3)+(lane>>2))*PQ+(wid>>2)*32+(lane&3)*8)*2u;
  const unsigned kdst=lds0+LDS_K+wid*1024, vdst=lds0+LDS_V+wid*1024;
  const lds_cptr shm3=(lds_cptr)shm; const lds_cptr kp0=shm3+LDS_K+hi*1024+r32*16; const lds_cptr vp0=shm3+LDS_V+((lane>>4)&1)*32+(lane&3)*8+(4*hi+((lane&15)>>2))*64;
  const int NT=(q0+QB)/KVBLK;
  unsigned long long apw_=0,apt0_=0; (void)apw_; (void)apt0_;
  const lds_cptr qp0=shm3+LDS_Q+wid*4096+lane*16;
  const bf16*kptr=A.K+rowbase*PQ+(h*2)*64,*vptr=A.V+rowbase*PQ+h*128;
  for(int mp=0;mp<2;++mp){
  const bf16*Qw=A.Q+(rowbase+q0+wid*QBLK)*PQ+(h*2+mp)*64;
  #define DMA_K(t,slot) do{ glds16(kptr,koff,(unsigned)__builtin_amdgcn_readfirstlane(kdst+(slot))); kptr+=KVBLK*PQ; }while(0)
  #define DMA_V(t,slot) do{ glds16(vptr,voff,(unsigned)__builtin_amdgcn_readfirstlane(vdst+(slot))); glds16(vptr,voff+128u,(unsigned)__builtin_amdgcn_readfirstlane(vdst+(slot)+8192)); vptr+=KVBLK*PQ; }while(0)
  if(mp==0){ DMA_K(0,0);DMA_V(0,0);DMA_K(1,KSLOT); }
  bf16x8 qr[4];
  { int lq_=lane; asm volatile("":"+v"(lq_)); const unsigned qoff_=(unsigned)((lq_&31)*PQ+(lq_>>5)*8);
  _Pragma("unroll") for(int d0=0;d0<4;++d0)qr[d0]=*reinterpret_cast<const bf16x8*>(Qw+qoff_+d0*16); }
  _Pragma("unroll") for(int d0=0;d0<4;++d0)*(__attribute__((address_space(3))) bf16x8*)(const_cast<__attribute__((address_space(3))) char*>(qp0)+d0*1024)=qr[d0];
  float mhat=0.f,l_reg=0.f;f32x16 o[4];o[0]=f32x16{};o[1]=f32x16{};o[2]=f32x16{};o[3]=f32x16{};
  const f32x16 zero16=f32x16{};
  #define CMASK(P0,P1,t) do{int jb_=(t)-(NT-4); if(jb_>=0){ const int lf_=fresh_lane(); cmask(P0,P1,jb_,wid*QBLK+(lf_&31),lf_>>5); } }while(0)
  bool resc=false;
  #define RESC() do{ if(resc){ asm volatile("s_waitcnt lgkmcnt(0)":::"memory"); \
      const int hf_=fresh_lane()>>5; const float*wf_=(const float*)(shm+LDS_WS)+wid*64; _Pragma("unroll") for(int d_=0;d_<4;++d_) _Pragma("unroll") for(int r=0;r<16;++r)o[d_][r]*=wf_[crow(r,hf_)]; } }while(0)
  f32x16 pA0,pA1,pB0,pB1; bf16x8 kf[8];
  int ks_cur=0,ks_next=KSLOT;
  int vs_prev=0,vs_cur=0,vs_next=VSLOT;
  #define ROT() do{ ks_cur=ks_next; ks_next=(ks_next==(NKS-1)*KSLOT)?0:ks_next+KSLOT; vs_prev=vs_cur; vs_cur=vs_next; vs_next=(vs_next==(NVS-1)*VSLOT)?0:vs_next+VSLOT; }while(0)
  if(mp==0){ DMA_K(2,2*KSLOT); WAIT_BAR(4); }
  else { WAIT_BAR(0); }
  { _Pragma("unroll") for(int i=0;i<8;++i)kf[i]=kld(kp0,i);
    pA0=MFMA32(kf[0],qr[0],zero16);pA1=MFMA32(kf[1],qr[0],zero16);pA0=MFMA32(kf[2],qr[1],pA0);pA1=MFMA32(kf[3],qr[1],pA1);
    pA0=MFMA32(kf[4],qr[2],pA0);pA1=MFMA32(kf[5],qr[2],pA1);pA0=MFMA32(kf[6],qr[3],pA0);pA1=MFMA32(kf[7],qr[3],pA1); }
  CMASK(pA0,pA1,0);
  { mhat=rowmax(pA0,pA1);
    _Pragma("unroll") for(int r=0;r<16;++r){pA0[r]=__builtin_amdgcn_exp2f(pA0[r]-mhat);pA1[r]=__builtin_amdgcn_exp2f(pA1[r]-mhat);} }
  WAIT_BAR(0);
  DMA_K(3,3*KSLOT);DMA_V(1,VSLOT);
  ROT();
  { const lds_cptr kq_=kp0+ks_cur; kf[0]=kld(kq_,0);kf[1]=kld(kq_,1);kf[2]=kld(kq_,2);kf[3]=kld(kq_,3); }
  bf16x8 qa=QL(0),qb_;
  s16x4 vlo[8],vhi[8],wlo[8],whi[8]; u32x4 pw0,pw1,pw2,pw3;
  #define PKW(P,B) cvtpk_s(P[B],P[B+1])
  #define PAF(k) __builtin_bit_cast(bf16x8,pw##k)
  #define VFR(i) (bf16x8){vlo[i][0],vlo[i][1],vlo[i][2],vlo[i][3],vhi[i][0],vhi[i][1],vhi[i][2],vhi[i][3]}
  #define WFR(i) (bf16x8){wlo[i][0],wlo[i][1],wlo[i][2],wlo[i][3],whi[i][0],whi[i][1],whi[i][2],whi[i][3]}
  #define PIN(x) asm volatile("":"+v"(x))
  #define GAPA(MF,A0,A1,A2,A3,W0,W1,PW) do{ MF; sacc+=A0; sacc+=A1; sacc+=A2; sacc+=A3; PIN(sacc); W0; W1; PIN(PW); SBAR(); }while(0)
  #define EX(v) __builtin_amdgcn_exp2f((v)-mhat)
  #define GAPB(MF,X,B) do{ MF; X[B]=EX(X[B]); X[B+1]=EX(X[B+1]); PIN(X); SBAR(); }while(0)
  #define VRD(i) do{ vlo[i]=vtr(vp_+(((i)>>2)*4096+((i)&3)*1024)); vhi[i]=vtr(vp_+(((i)>>2)*4096+((i)&3)*1024+512)); }while(0)
  #define WRD(i) do{ wlo[i]=vtr(vp_+(8192+((i)>>2)*4096+((i)&3)*1024)); whi[i]=vtr(vp_+(8192+((i)>>2)*4096+((i)&3)*1024+512)); SBAR(); }while(0)
  #define KJ(i) do{ kf[i]=kld(kq_,i); }while(0)
  #define KRD(G,i) do{ if(G){ kf[i]=kld(kn_,i); SBAR(); } }while(0)
  #define STEP(C0,C1,P0,P1,t,GK,GV,GL) do{ SBAR(); \
    const lds_cptr vp_=vp0+vs_prev; const lds_cptr kq_=kp0+ks_cur; const lds_cptr kn_=kp0+ks_next; \
    VRD(0); KJ(4); qb_=QL(1); SBAR(); float sacc=(P0[0]+P0[1]); \
    GAPA(C0=MFMA32(kf[0],qa,zero16), P0[2],P0[3],P0[4],P0[5],     pw0[0]=PKW(P0,0), pw0[1]=PKW(P0,2), pw0); \
    VRD(4); KJ(5); SBAR(); GAPA(C1=MFMA32(kf[1],qa,zero16), P0[6],P0[7],P0[8],P0[9],     pw0[2]=PKW(P0,4), pw0[3]=PKW(P0,6), pw0); \
    VRD(1); KJ(6); qa=QL(2); SBAR(); GAPA(C0=MFMA32(kf[2],qb_,C0),   P0[10],P0[11],P0[12],P0[13], pw1[0]=PKW(P0,8), pw1[1]=PKW(P0,10), pw1); \
    VRD(5); KJ(7); SBAR(); GAPA(C1=MFMA32(kf[3],qb_,C1),   P0[14],P0[15],P1[0],P1[1],   pw1[2]=PKW(P0,12),pw1[3]=PKW(P0,14), pw1); \
    VRD(2); qb_=QL(3); SBAR(); GAPA(C0=MFMA32(kf[4],qa,C0),   P1[2],P1[3],P1[4],P1[5],     pw2[0]=PKW(P1,0), pw2[1]=PKW(P1,2), pw2); \
    VRD(6); SBAR(); GAPA(C1=MFMA32(kf[5],qa,C1),   P1[6],P1[7],P1[8],P1[9],     pw2[2]=PKW(P1,4), pw2[3]=PKW(P1,6), pw2); \
    VRD(3); SBAR(); GAPA(C0=MFMA32(kf[6],qb_,C0),   P1[10],P1[11],P1[12],P1[13], pw3[0]=PKW(P1,8), pw3[1]=PKW(P1,10), pw3); \
    VRD(7); SBAR(); GAPA(C1=MFMA32(kf[7],qb_,C1),   P1[14],P1[15],0.f,0.f,       pw3[2]=PKW(P1,12),pw3[3]=PKW(P1,14), pw3); \
    l_reg+=sacc; \
    if(GK){DMA_K((t)+3,(ks_cur==0)?(NKS-1)*KSLOT:ks_cur-KSLOT);} if(GV){DMA_V((t)+1,vs_next);} \
    CMASK(C0,C1,t); \
    { float rm=rowmax(C0,C1)-mhat; \
      resc=false; \
      if(__builtin_expect(__any(rm>(float)THRL),0)){ const float dl=__builtin_fmaxf(rm,0.f); mhat+=dl; \
        const float f=__builtin_amdgcn_exp2f(-dl); l_reg*=f; { const int lf_=fresh_lane(); if(lf_<32)((float*)(shm+LDS_WS))[wid*64+lf_]=f; } resc=true; } } \
    SBAR(); \
    GAPB(o[0]=MFMA32(PAF(0),VFR(0),o[0]), C0,0);  WRD(0); \
    GAPB(o[1]=MFMA32(PAF(0),VFR(4),o[1]), C0,2);  WRD(4); \
    GAPB(o[0]=MFMA32(PAF(1),VFR(1),o[0]), C0,4);  WRD(1); \
    GAPB(o[1]=MFMA32(PAF(1),VFR(5),o[1]), C0,6);  WRD(5); \
    GAPB(o[0]=MFMA32(PAF(2),VFR(2),o[0]), C0,8);  WRD(2); \
    GAPB(o[1]=MFMA32(PAF(2),VFR(6),o[1]), C0,10); WRD(6); \
    GAPB(o[0]=MFMA32(PAF(3),VFR(3),o[0]), C0,12); WRD(3); \
    GAPB(o[1]=MFMA32(PAF(3),VFR(7),o[1]), C0,14); WRD(7); \
    GAPB(o[2]=MFMA32(PAF(0),WFR(0),o[2]), C1,0); \
    GAPB(o[3]=MFMA32(PAF(0),WFR(4),o[3]), C1,2); \
    GAPB(o[2]=MFMA32(PAF(1),WFR(1),o[2]), C1,4); \
    GAPB(o[3]=MFMA32(PAF(1),WFR(5),o[3]), C1,6); \
    KRD(GL,0); GAPB(o[2]=MFMA32(PAF(2),WFR(2),o[2]), C1,8); \
    KRD(GL,1); GAPB(o[3]=MFMA32(PAF(2),WFR(6),o[3]), C1,10); \
    KRD(GL,2); GAPB(o[2]=MFMA32(PAF(3),WFR(3),o[2]), C1,12); \
    KRD(GL,3); if(GL){qa=QL(0);SBAR();} GAPB(o[3]=MFMA32(PAF(3),WFR(7),o[3]), C1,14); \
    }while(0)
  int t=1;
  #undef CMASK
  #define CMASK(P0,P1,t) do{}while(0)
  for(;t+5<NT;t+=2){
    STEP(pB0,pB1,pA0,pA1,t,true,true,true);     APB0(); APW(3); APB1(); WAIT_BAR(3); RESC(); ROT();
    STEP(pA0,pA1,pB0,pB1,t+1,true,true,true);   APB0(); APW(3); APB1(); WAIT_BAR(3); RESC(); ROT();
  }
  #undef CMASK
  #define CMASK(P0,P1,t) do{int jb_=(t)-(NT-4); if(jb_>=0){ const int lf_=fresh_lane(); cmask(P0,P1,jb_,wid*QBLK+(lf_&31),lf_>>5); } }while(0)
  #define ENDW(tt) do{ if((tt)+3<NT){WAIT_BAR(3);} else if((tt)+2<NT){WAIT_BAR(2);} else {WAIT_BAR(0);} }while(0)
  for(;t+1<NT;t+=2){
    STEP(pB0,pB1,pA0,pA1,t,(t+3<NT),(t+1<NT),(t+1<NT));       ENDW(t);   RESC(); ROT();
    STEP(pA0,pA1,pB0,pB1,t+1,(t+4<NT),(t+2<NT),(t+2<NT));     ENDW(t+1); RESC(); ROT();
  }
  STEP(pB0,pB1,pA0,pA1,NT-1,false,false,false); RESC();
  { float sacc=pB0[0]+pB0[1]; _Pragma("unroll") for(int r=2;r<16;++r)sacc+=pB0[r]; _Pragma("unroll") for(int r=0;r<16;++r)sacc+=pB1[r]; l_reg+=sacc;
    pw0=(u32x4){PKW(pB0,0),PKW(pB0,2),PKW(pB0,4),PKW(pB0,6)};pw1=(u32x4){PKW(pB0,8),PKW(pB0,10),PKW(pB0,12),PKW(pB0,14)};pw2=(u32x4){PKW(pB1,0),PKW(pB1,2),PKW(pB1,4),PKW(pB1,6)};pw3=(u32x4){PKW(pB1,8),PKW(pB1,10),PKW(pB1,12),PKW(pB1,14)};
    SBAR(); const lds_cptr vp_=vp0+vs_cur;
    _Pragma("unroll") for(int qd=0;qd<4;++qd){ s16x4 lo_[4],hi_[4];
      _Pragma("unroll") for(int ks=0;ks<4;++ks){ lo_[ks]=vtr(vp_+(qd*4096+ks*1024)); hi_[ks]=vtr(vp_+(qd*4096+ks*1024+512)); }
      #define PK_(k) (bf16x8){lo_[k][0],lo_[k][1],lo_[k][2],lo_[k][3],hi_[k][0],hi_[k][1],hi_[k][2],hi_[k][3]}
      o[qd]=MFMA32(PAF(0),PK_(0),o[qd]); o[qd]=MFMA32(PAF(1),PK_(1),o[qd]); o[qd]=MFMA32(PAF(2),PK_(2),o[qd]); o[qd]=MFMA32(PAF(3),PK_(3),o[qd]);
      #undef PK_
    } }
  #undef STEP
  #undef ENDW
  #undef CMASK
  asm volatile("s_waitcnt lgkmcnt(0)\n\ts_barrier":::"memory");
  unsigned pk_[32];
  if(mp==1){ int lp_=lane; asm volatile("":"+v"(lp_)); const unsigned*pp_=A.park+wid*2048+lp_*4;
    _Pragma("unroll") for(int i4=0;i4<8;++i4){ const u32x4 q_=*(const u32x4*)(pp_+(size_t)i4*256); pk_[4*i4]=q_[0];pk_[4*i4+1]=q_[1];pk_[4*i4+2]=q_[2];pk_[4*i4+3]=q_[3]; } }
  if(mp==0){ kptr=A.K+rowbase*PQ+(h*2+1)*64; vptr=A.V+rowbase*PQ+h*128; DMA_K(0,0);DMA_V(0,0);DMA_K(1,KSLOT);DMA_K(2,2*KSLOT); }
  int le_=lane; asm volatile("":"+v"(le_)); const int r32e=le_&31,hie=le_>>5; float*wse=(float*)(shm+LDS_WS)+wid*64; unsigned*parke=A.park+wid*2048+le_*4;
  {auto rr=__builtin_amdgcn_permlane32_swap(__float_as_uint(l_reg),__float_as_uint(l_reg),false,false);l_reg=__uint_as_float(rr[0])+__uint_as_float(rr[1]);}
  if(hie==0)wse[32+r32e]=l_reg;asm volatile("s_waitcnt lgkmcnt(0)":::"memory");
  float rli[16];
  #pragma unroll
  for(int r=0;r<16;++r)rli[r]=__builtin_amdgcn_rcpf(wse[32+crow(r,hie)]);
  if(mp==0){
    #pragma unroll
    for(int d0=0;d0<4;++d0)
      #pragma unroll
      for(int r=0;r<16;r+=8){ u32x4 q_; q_[0]=cvtpk_s(o[d0][r]*rli[r],o[d0][r+1]*rli[r+1]); q_[1]=cvtpk_s(o[d0][r+2]*rli[r+2],o[d0][r+3]*rli[r+3]); q_[2]=cvtpk_s(o[d0][r+4]*rli[r+4],o[d0][r+5]*rli[r+5]); q_[3]=cvtpk_s(o[d0][r+6]*rli[r+6],o[d0][r+7]*rli[r+7]);
        *(u32x4*)(parke+(size_t)(d0*2+(r>>3))*256)=q_; }
  } else {
    float ss[16];
    #pragma unroll
    for(int r=0;r<16;++r)ss[r]=0.f;
    #pragma unroll
    for(int d0=0;d0<4;++d0)
      #pragma unroll
      for(int r=0;r<16;r+=2){ const unsigned w=pk_[d0*8+(r>>1)];
        const float d_lo=__uint_as_float(w<<16)-A.lam*(o[d0][r]*rli[r]), d_hi=__uint_as_float(w&0xffff0000u)-A.lam*(o[d0][r+1]*rli[r+1]);
        o[d0][r]=d_lo; o[d0][r+1]=d_hi; ss[r]+=d_lo*d_lo; ss[r+1]+=d_hi*d_hi; }
    float gn[4];
    #pragma unroll
    for(int d0=0;d0<4;++d0)gn[d0]=A.subln[32*d0+r32e]*A.post;
    #pragma unroll
    for(int r=0;r<16;++r){ float s=ss[r];
      s+=__int_as_float(__builtin_amdgcn_update_dpp(0,__float_as_int(s),0x128,0xf,0xf,false));
      s+=__int_as_float(__builtin_amdgcn_update_dpp(0,__float_as_int(s),0x124,0xf,0xf,false));
      s+=__int_as_float(__builtin_amdgcn_update_dpp(0,__float_as_int(s),0x122,0xf,0xf,false));
      s+=__int_as_float(__builtin_amdgcn_update_dpp(0,__float_as_int(s),0x121,0xf,0xf,false));
      auto rr=__builtin_amdgcn_permlane16_swap(__float_as_uint(s),__float_as_uint(s),false,false);
      ss[r]=__builtin_amdgcn_rsqf((__uint_as_float(rr[0])+__uint_as_float(rr[1]))*(1.0f/128.0f)+1e-6f); }
    bf16*stg=(bf16*)(shm+LDS_Q+wid*4096);
    bf16*Ow=A.MIX+(rowbase+q0+wid*QBLK)*PM+512+h*128;
    const int lo_=le_; const unsigned ooff_=(unsigned)((lo_>>3)*PM+(lo_&7)*8);
    #pragma unroll
    for(int hf=0;hf<2;++hf){
      #pragma unroll
      for(int r=0;r<16;++r){ const int orow=crow(r,hie);
        #pragma unroll
        for(int d0=0;d0<2;++d0)((unsigned short*)stg)[orow*64+d0*32+r32e]=(unsigned short)cvtpk_s(o[2*hf+d0][r]*ss[r]*gn[2*hf+d0],0.f); }
      asm volatile("s_waitcnt lgkmcnt(0)":::"memory");
      _Pragma("unroll") for(int i=0;i<4;++i){const int row=i*8+(lo_>>3),ch=lo_&7; const u32x4 v=*(const u32x4*)(stg+row*64+ch*8); *(u32x4*)(Ow+ooff_+i*8*PM+hf*64)=v;}
      asm volatile("s_waitcnt lgkmcnt(0)":::"memory");
    }
  }
  ATTN_PROBE_OUT();
  #undef DMA_K
  #undef DMA_V
  #undef RESC
  #undef ROT
  #undef PKW
  #undef PAF
  #undef VFR
  #undef WFR
  #undef PIN
  #undef GAPA
  #undef GAPB
  #undef EX
  #undef VRD
  #undef WRD
  #undef KJ
  #undef KRD
  }
}
constexpr int ATTN_LDS_BYTES=LDS_BYTES;
template<int THRL=8> __device__ __forceinline__ void attn_phase(char*lds,const AttnArgs&A,int vcu,int G,const int tid){
  for(int slot=vcu;slot<256;slot+=G){ const int bh=slot>>3,s=slot&7;
    attn_unit<THRL>(tid,bh>>2,bh&3,15-s,A,lds); attn_unit<THRL>(tid,bh>>2,bh&3,s,A,lds); }
}
#undef SBAR
#undef WAIT_BAR
#undef MX3
#undef MFMA32
}
namespace cg = cooperative_groups;
#define GAS __attribute__((address_space(1)))
#define LAS __attribute__((address_space(3)))
typedef unsigned short bf16;
typedef unsigned v4u __attribute__((ext_vector_type(4)));
typedef unsigned v2u __attribute__((ext_vector_type(2)));
typedef float f32x4 __attribute__((ext_vector_type(4)));
typedef short bf16x8 __attribute__((ext_vector_type(8)));

constexpr int NB = 8, SEQ = 4096, M = NB * SEQ, DMODEL = 1024, DEPTH = 2;
constexpr int D_SGU = 512, D_ATT = 512, D_IN = 2560, D_FF = 2816, NUP = 2 * D_FF;
constexpr float EPS = 1e-6f;
constexpr float C2 = 0.125f * 1.4426950408889634f;
constexpr size_t MiB = 1u << 20;
constexpr size_t WS_W = 1 * MiB, W_LAYER = 24 * MiB;
constexpr size_t W_IN = 0, W_OUT = 5 * MiB, W_UP = 7 * MiB, W_DN = 18 * MiB;
constexpr size_t WS_COS = 49 * MiB, WS_SIN = 50 * MiB;
constexpr size_t WS_PART = 51 * MiB;
constexpr size_t WS_TOP = 53 * MiB, WS_BOT = 75 * MiB;
constexpr size_t WS_HB = 97 * MiB;
constexpr size_t WS_MIX = 161 * MiB;
constexpr size_t WS_R = 225 * MiB;
constexpr size_t SEG = (size_t)M * 512;
constexpr size_t WS_O = WS_R + 5 * SEG * 2;
constexpr size_t WS_END = WS_O + (size_t)M * 1024 * 2;
constexpr size_t WS_PARK = 449 * MiB;
constexpr size_t WS_TOTAL = WS_PARK + 16 * MiB;
static_assert(WS_END == 449 * MiB && WS_R + (size_t)M * pg8::ACT_LD * 2 <= WS_END && (size_t)DMODEL * pg8::ACT_LD * 2 <= 6 * MiB, "d_ws map");
constexpr size_t WS_CTL = 0; constexpr int CW_BAR = 4096;
constexpr int XCH_OFF = 131072;
constexpr int MISC_OFF = 150528;
constexpr int LDS_BYTES = 151552;
constexpr int NPH = 16;

__device__ __forceinline__ float bf2f(unsigned b) { return __uint_as_float(b << 16); }
__device__ __forceinline__ unsigned pk2(float lo, float hi) { return pg8::cvt_pk_bf16(lo, hi); }
__device__ __forceinline__ float shx(float v, int lane, int mask) { return __int_as_float(__builtin_amdgcn_ds_bpermute(4 * (lane ^ mask), __float_as_int(v))); }
__device__ __forceinline__ float wave_sum(float v, int lane) {
#pragma unroll
    for (int o = 1; o < 64; o <<= 1) v += shx(v, lane, o);
    return v;
}
#define LDS_WAIT() asm volatile("s_waitcnt lgkmcnt(0)" ::: "memory")

#define RLX_AGENT __ATOMIC_RELAXED, __HIP_MEMORY_SCOPE_AGENT
#define XB_TMO      128
#define XB_XCNT(j)  (256  + 64 * (j))
#define XB_XSUB(j)  (1280 + 64 * (j))
#define XB_XGEN(j)  (2304 + 64 * (j))
#define XB_TOP      3328
#define XB_TOPGEN   3392
#define XCD_BAR_WORDS 3456
#define XB_SPIN_CAP (1u << 18)

__device__ __forceinline__ unsigned xb_ld(unsigned* p)              { return __hip_atomic_load(p, __ATOMIC_RELAXED, __HIP_MEMORY_SCOPE_AGENT); }
__device__ __forceinline__ unsigned xb_add(unsigned* p, unsigned v) { return __hip_atomic_fetch_add(p, v, __ATOMIC_RELAXED, __HIP_MEMORY_SCOPE_AGENT); }
__device__ __forceinline__ unsigned xb_xcc_id() { return (unsigned)__builtin_amdgcn_s_getreg((3 << 11) | 20) & 0xFu; }
#define XB_SPIN(cond, bar) do { unsigned _sp = 0; while (cond) { __builtin_amdgcn_s_sleep(1); \
    if ((++_sp & 255u) == 0u) { if (xb_ld(&(bar)[XB_TMO])) break; if (_sp > XB_SPIN_CAP) { atomicAdd(&(bar)[XB_TMO], 1u); break; } } } } while (0)

struct XcdBarrier {
    unsigned* bar; unsigned x;
    volatile LAS unsigned* st;
};

__device__ __forceinline__ XcdBarrier xcd_barrier_post(unsigned* bar, volatile LAS unsigned* st, bool is_t0) {
    XcdBarrier b; b.bar = bar; b.x = xb_xcc_id(); b.st = st;
    if (is_t0) (void)xb_add(&bar[XB_XCNT(b.x)], 1u);
    return b;
}
__device__ __forceinline__ void xcd_barrier_complete(unsigned* bar, unsigned x, unsigned& nloc, unsigned& nx) {
    const unsigned G = gridDim.x * gridDim.y * gridDim.z;
    unsigned sum, cnt, mine, sp = 0u;
    for (;;) {
        sum = 0u; cnt = 0u; mine = 0u;
#pragma unroll
        for (unsigned j = 0; j < 16; ++j) { const unsigned c = xb_ld(&bar[XB_XCNT(j)]); sum += c; cnt += (c > 0u) ? 1u : 0u; mine = (j == x) ? c : mine; }
        if (sum == G) break;
        __builtin_amdgcn_s_sleep(1);
        if ((++sp & 255u) == 0u) { if (xb_ld(&bar[XB_TMO])) break; if (sp > XB_SPIN_CAP) { atomicAdd(&bar[XB_TMO], 1u); break; } }
    }
    nloc = mine > 0u ? mine : 1u; nx = cnt > 0u ? cnt : 1u;
}

__device__ __forceinline__ void xcd_barrier(const XcdBarrier& b, bool is_t0) {
    asm volatile("s_waitcnt vmcnt(0)" ::: "memory");
    __syncthreads();
    if (is_t0) {
        unsigned* bar = b.bar;
        __builtin_amdgcn_s_waitcnt(0);
        unsigned nloc = b.st[0], nx = b.st[1];
        if (nloc == 0u) { xcd_barrier_complete(bar, b.x, nloc, nx); b.st[0] = nloc; b.st[1] = nx; }
        const unsigned old = xb_add(&bar[XB_XSUB(b.x)], 1u);
        const unsigned gen = old / nloc;
        if (old + 1u == (gen + 1u) * nloc) {
            __builtin_amdgcn_fence(__ATOMIC_RELEASE, "agent");
            asm volatile("s_waitcnt vmcnt(0)" ::: "memory");
            const unsigned og = xb_add(&bar[XB_TOP], 1u);
            const unsigned tg = og / nx;
            if (og + 1u == (tg + 1u) * nx) xb_add(&bar[XB_TOPGEN], 1u);
            else XB_SPIN(xb_ld(&bar[XB_TOPGEN]) == tg, bar);
            __builtin_amdgcn_fence(__ATOMIC_ACQUIRE, "agent");
            xb_add(&bar[XB_XGEN(b.x)], 1u);
            asm volatile("s_waitcnt vmcnt(0)" ::: "memory");
        } else {
            XB_SPIN(xb_ld(&bar[XB_XGEN(b.x)]) == gen, bar);
            __builtin_amdgcn_fence(__ATOMIC_ACQUIRE, "agent");
            asm volatile("s_waitcnt vmcnt(0)" ::: "memory");
        }
    }
    __syncthreads();
}


template <int MODE> __device__ __forceinline__ int wrow_map(int n) {
    if (MODE == 1) { if (n >= 1024 && n < 2048) { const int d = n & 63; if (d < 16) return (n - d) + (d < 8 ? 2 * d : 2 * (d - 8) + 1); } return n; }
    if (MODE == 2) { return n < D_FF ? (n >> 7) * 256 + (n & 127) : ((n - D_FF) >> 7) * 256 + 128 + ((n - D_FF) & 127); }
    return n;
}
template <int MODE> __device__ __forceinline__ void p0_transpose_item(const float* W, const float* gk, int K, int N, bf16* WT, LAS float* scr, int item, int lane, int ldw = 0) {
    const int nblk = N / 32, kb = item / nblk, nb = item % nblk, k0 = 64 * kb, n0 = 32 * nb;
    float wv[32];
#pragma unroll
    for (int i = 0; i < 32; ++i) wv[i] = W[(size_t)(k0 + 2 * i + (lane >> 5)) * N + n0 + (lane & 31)];
#pragma unroll
    for (int i = 0; i < 32; ++i) scr[(2 * i + (lane >> 5)) * 33 + (lane & 31)] = wv[i];
    LDS_WAIT(); asm volatile("" ::: "memory");
    const int c = lane & 7;
    f32x4 ga = {1.f, 1.f, 1.f, 1.f}, gb = {1.f, 1.f, 1.f, 1.f};
    if (gk) { ga = *(const f32x4*)(gk + k0 + 8 * c); gb = *(const f32x4*)(gk + k0 + 8 * c + 4); }
#pragma unroll
    for (int j = 0; j < 4; ++j) { const int n = (lane >> 3) + 8 * j; const LAS float* s = scr + (8 * c) * 33 + n;
        v4u o; o.x = pk2(s[0 * 33] * ga[0], s[1 * 33] * ga[1]); o.y = pk2(s[2 * 33] * ga[2], s[3 * 33] * ga[3]); o.z = pk2(s[4 * 33] * gb[0], s[5 * 33] * gb[1]); o.w = pk2(s[6 * 33] * gb[2], s[7 * 33] * gb[3]);
        *(v4u*)(WT + (size_t)wrow_map<MODE>(n0 + n) * (ldw ? ldw : K) + k0 + 8 * c) = o; }
    LDS_WAIT(); asm volatile("" ::: "memory");
}

__device__ __forceinline__ const void* karg(int i) {
    unsigned off = 8u * (unsigned)i; asm volatile("" : "+s"(off));
    return *(const void* const __attribute__((address_space(4)))*)((const char __attribute__((address_space(4)))*)__builtin_amdgcn_kernarg_segment_ptr() + off);
}
#define KIN(i) ((const float*)karg(i))
#define KOUT() ((float*)karg(19))
#define KWS() ((unsigned char*)karg(20))
#ifndef MK_MASK
#define MK_MASK 0x3ff
#endif
#define HAVE(k) (((MK_MASK) >> (k)) & 1)
#ifndef MK_TSOFF
#define MK_TSOFF 0
#endif
#if MK_TS >= 0
#define MK_STAMP(k, t0) do { if ((t0) && blockIdx.x == 0) { ((unsigned long long*)(KWS() + 65536))[(k) + 1] = __builtin_amdgcn_s_memrealtime(); ((unsigned long long*)(KWS() + 65536))[(k) + 33] = __builtin_readcyclecounter(); } } while (0)
#else
#define MK_STAMP(k, t0) do {} while (0)
#endif
#define MK_IDS \
    int zz_; asm volatile("s_mov_b32 %0, 0" : "=s"(zz_)); \
    const int lane = __builtin_amdgcn_mbcnt_hi(~0u, __builtin_amdgcn_mbcnt_lo(~0u, (unsigned)zz_)), wave = wave_s; const int tid = wave * 64 + lane; \
    int G = gridDim.x, bx = blockIdx.x; asm volatile("" : "+s"(G), "+s"(bx)); \
    const int vcu = (G % 8 == 0) ? (bx % 8) * (G / 8) + bx / 8 : bx;     \
    const int gw = vcu * 8 + wave, NGW = G * 8; (void)lane; (void)gw; (void)NGW; (void)vcu; (void)tid;
struct Args { const void* in[19]; float* out; unsigned char* ws; int ph_lo, ph_hi; };

__global__ void __launch_bounds__(512, 2) mk_fwd(Args args) {
    extern __shared__ __attribute__((aligned(16))) unsigned char lds[];
    cg::grid_group grid = cg::this_grid();
    int wave_s; { const int t0_ = threadIdx.x; wave_s = __builtin_amdgcn_readfirstlane(t0_ >> 6); asm volatile("" : "+s"(wave_s));
        if (t0_ < 16) ((volatile LAS unsigned*)((LAS unsigned char*)lds + MISC_OFF))[t0_] = 0u;
        if (args.ph_lo < 0) grid.sync();
        __syncthreads(); }
    { const bool t0b_ = (wave_s == 0) && (__builtin_amdgcn_mbcnt_hi(~0u, __builtin_amdgcn_mbcnt_lo(~0u, 0u)) == 0);
      (void)xcd_barrier_post((unsigned*)(args.ws + WS_CTL) + CW_BAR, (volatile LAS unsigned*)((LAS unsigned char*)lds + MISC_OFF) + 8, t0b_); }
    const int lo = args.ph_lo, hi = args.ph_hi;
#if MK_TS >= 0
    if (wave_s == 0 && blockIdx.x == 0 && __builtin_amdgcn_mbcnt_hi(~0u, __builtin_amdgcn_mbcnt_lo(~0u, 0u)) == 0) ((unsigned long long*)(args.ws + 65536))[0] = __builtin_amdgcn_s_memrealtime();
#endif
#define IN(k) (lo <= (k) && (k) < hi)
#define SEAM(k) do { if (IN(k) && IN((k) + 1)) { int zb_; asm volatile("s_mov_b32 %0, 0" : "=s"(zb_)); \
        const bool t0b_ = (wave_s == 0) && (__builtin_amdgcn_mbcnt_hi(~0u, __builtin_amdgcn_mbcnt_lo(~0u, (unsigned)zb_)) == 0); \
        XcdBarrier xb_; xb_.bar = (unsigned*)(KWS() + WS_CTL) + CW_BAR; xb_.x = xb_xcc_id(); xb_.st = (volatile LAS unsigned*)((LAS unsigned char*)lds + MISC_OFF) + 8; xcd_barrier(xb_, t0b_); MK_STAMP(k, t0b_); } } while (0)

    if (HAVE(0) && IN(0)) {
        MK_IDS
        LAS float* scr = (LAS float*)((LAS unsigned char*)lds + wave * 16384);
        unsigned char* ws = KWS(); const float* w_in = KIN(3); const float* w_out = KIN(12); const float* w_up = KIN(14); const float* w_down = KIN(17);
        constexpr int I_IN = (DMODEL / 64) * (D_IN / 32), I_OUT = (DMODEL / 64) * (DMODEL / 32), I_UP = (DMODEL / 64) * (NUP / 32), I_DN = (D_FF / 64) * (DMODEL / 32);
        constexpr int I_L = I_IN + I_OUT + I_UP + I_DN;
        for (int it = gw; it < DEPTH * I_L; it += NGW) {
            const int l = it / I_L; int r = it % I_L; unsigned char* wl = ws + WS_W + (size_t)l * W_LAYER;
            if (r < I_IN) { p0_transpose_item<1>(w_in + (size_t)l * DMODEL * D_IN, KIN(2) + (size_t)l * DMODEL, DMODEL, D_IN, (bf16*)(wl + W_IN), scr, r, lane); continue; } r -= I_IN;
            if (r < I_OUT) { p0_transpose_item<0>(w_out + (size_t)l * DMODEL * DMODEL, nullptr, DMODEL, DMODEL, (bf16*)(wl + W_OUT), scr, r, lane); continue; } r -= I_OUT;
            if (r < I_UP) { p0_transpose_item<2>(w_up + (size_t)l * DMODEL * NUP, KIN(13) + (size_t)l * DMODEL, DMODEL, NUP, (bf16*)(wl + W_UP), scr, r, lane); continue; } r -= I_UP;
            p0_transpose_item<0>(w_down + (size_t)l * D_FF * DMODEL, nullptr, D_FF, DMODEL, (bf16*)(wl + W_DN), scr, r, lane, pg8::ACT_LD);
        }
        const float* x = KIN(0); const int* positions = (const int*)karg(1);
        bf16* HB = (bf16*)(ws + WS_HB); float* PART = (float*)(ws + WS_PART); float* COS = (float*)(ws + WS_COS); float* SIN = (float*)(ws + WS_SIN);
        for (int m0 = gw; m0 < M; m0 += 4 * NGW) {
            f32x4 v[4][4]; int pos[4];
#pragma unroll
            for (int k = 0; k < 4; ++k) { const int m = (m0 + k * NGW < M) ? m0 + k * NGW : m0; const f32x4* xr = (const f32x4*)(x + (size_t)m * DMODEL) + lane;
#pragma unroll
                for (int j = 0; j < 4; ++j) v[k][j] = xr[64 * j];
                pos[k] = positions[m]; }
#pragma unroll
            for (int k = 0; k < 4; ++k) { const int m = m0 + k * NGW; if (m < M) {
                unsigned long long* o8 = (unsigned long long*)(HB + (size_t)m * DMODEL) + lane; float s = 0.f;
#pragma unroll
                for (int j = 0; j < 4; ++j) { const f32x4 w = v[k][j]; s += (w.x * w.x + w.y * w.y) + (w.z * w.z + w.w * w.w);
                    o8[64 * j] = (unsigned long long)pk2(w.x, w.y) | ((unsigned long long)pk2(w.z, w.w) << 32); }
                s = wave_sum(s, lane);
                if (lane < 4) PART[(size_t)m * 4 + lane] = (lane == 0) ? s : 0.f;
                if (lane < 8) {
                    const float inv_freq = exp2f(-(float)lane * 0.125f * 18.931568569324174f);
                    const float ang = (float)pos[k] * inv_freq;
                    const double rev = (double)ang * 0.15915494309189535; const float fr = (float)(rev - rint(rev));
                    COS[(size_t)m * 8 + lane] = __builtin_amdgcn_cosf(fr); SIN[(size_t)m * 8 + lane] = __builtin_amdgcn_sinf(fr);
                } } }
        }
    }
    SEAM(0);

    for (int l = 0; l < DEPTH; ++l) {
        const int pb = 1 + 7 * l;
        const float lambda_init = (l == 0) ? 0.2f : 0.35550906759096314f;
        if (HAVE(1) && IN(pb + 0)) {
            MK_IDS
            unsigned char* ws = KWS(); unsigned char* wl = ws + WS_W + (size_t)l * W_LAYER;
            pg8::Gemm g{(const bf16*)(ws + WS_HB), (const bf16*)(wl + W_IN), M, D_IN, DMODEL, DMODEL}; pg8::StaticOrder S; S.init(M, D_IN, G, bx);
            pg8::EpiInProj E{(const float*)(ws + WS_PART), (const float*)(ws + WS_COS), (const float*)(ws + WS_SIN), (bf16*)(ws + WS_R), C2, SEG, (LAS unsigned char*)lds};
            pg8::gemm_phase<pg8::EpiInProj, pg8::StaticOrder, true, true>((LAS unsigned char*)lds, g, S, E, tid);
        }
        SEAM(pb + 0);
        if (IN(pb + 1)) {
            {
            MK_IDS
            unsigned char* ws = KWS(); bf16* R = (bf16*)(ws + WS_R); bf16* MIX = (bf16*)(ws + WS_MIX);
            float d1 = KIN(7)[l * 64 + lane] * KIN(8)[l * 64 + lane], d2 = KIN(9)[l * 64 + lane] * KIN(10)[l * 64 + lane];
            d1 = wave_sum(d1, lane); d2 = wave_sum(d2, lane);
            const attn_body::AttnArgs AT{(const attn_body::bf16*)(R + 2 * SEG), (const attn_body::bf16*)(R + 3 * SEG), (const attn_body::bf16*)(R + 4 * SEG), (attn_body::bf16*)MIX,
                                         KIN(11) + l * 128, (unsigned*)(ws + WS_PARK) + (size_t)bx * 16384, expf(d1) - expf(d2) + lambda_init, 1.0f - lambda_init};
            static_assert(attn_body::ATTN_LDS_BYTES <= MISC_OFF, "attention LDS vs control words");
            if (HAVE(2)) attn_body::attn_phase<8>((char*)lds, AT, vcu, G, tid);
            }
            MK_IDS
            unsigned char* ws = KWS(); bf16* R = (bf16*)(ws + WS_R); bf16* MIX = (bf16*)(ws + WS_MIX);
            const bf16* U = R; const bf16* VS = R + SEG;
            LAS bf16* vimg = (LAS bf16*)lds;
            LAS float* rsq = (LAS float*)((LAS unsigned char*)lds + 36864);
            const float* Wg_l = KIN(5) + (size_t)l * 4 * 128 * 128; const float* bs_l = KIN(6) + (size_t)l * 4 * 128; const float* vn_l = KIN(4) + (size_t)l * D_SGU;
            if (HAVE(3)) {
                const int p = 16 * wave + (lane & 15), kq = 8 * (lane >> 4); const int nks = (wave >> 1) + 1; const int dch = tid & 15;
                v4u raw[4];
                int unit = vcu;
                { const int u0 = unit < NB * 32 * 4 ? unit : 0; const int g = u0 & 3, t0 = (u0 >> 7) * SEQ + ((u0 >> 2) & 31) * 128;
#pragma unroll
                    for (int i = 0; i < 4; ++i) raw[i] = *(const v4u*)(VS + (size_t)(t0 + (tid >> 4) + 32 * i) * 512 + g * 128 + 8 * dch); }
                for (; unit < NB * 32 * 4; unit += G) {
                    const int g = unit & 3, ck = (unit >> 2) & 31, b = unit >> 7; const int t0 = b * SEQ + ck * 128;
                    float wreg[4][8]; const float bias = bs_l[g * 128 + p];
#pragma unroll
                    for (int ks = 0; ks < 4; ++ks) { const int q0 = 32 * ks + kq; const float* wp = Wg_l + ((size_t)g * 128 + p) * 128 + q0;
                        f32x4 w0 = {0.f, 0.f, 0.f, 0.f}, w1 = {0.f, 0.f, 0.f, 0.f};
                        if (ks < nks) { w0 = *(const f32x4*)wp; w1 = *(const f32x4*)(wp + 4); }
#pragma unroll
                        for (int jj = 0; jj < 8; ++jj) { const float w = jj < 4 ? w0[jj] : w1[jj - 4]; wreg[ks][jj] = (q0 + jj > p) ? 0.f : w; } }
                    v4u ur[4];
#pragma unroll
                    for (int k = 0; k < 4; ++k) ur[k] = *(const v4u*)(U + (size_t)(t0 + p) * 512 + g * 128 + 32 * k + 8 * (lane >> 4));
                    const f32x4 ga = *(const f32x4*)(vn_l + g * 128 + 8 * dch), gb = *(const f32x4*)(vn_l + g * 128 + 8 * dch + 4);
#pragma unroll
                    for (int i = 0; i < 4; ++i) { const int q = (tid >> 4) + 32 * i; const v4u r = raw[i];
                        const float f0 = bf2f(r.x & 0xffffu), f1 = bf2f(r.x >> 16), f2 = bf2f(r.y & 0xffffu), f3 = bf2f(r.y >> 16), f4 = bf2f(r.z & 0xffffu), f5 = bf2f(r.z >> 16), f6 = bf2f(r.w & 0xffffu), f7 = bf2f(r.w >> 16);
                        float ss = ((f0 * f0 + f1 * f1) + (f2 * f2 + f3 * f3)) + ((f4 * f4 + f5 * f5) + (f6 * f6 + f7 * f7));
                        ss += shx(ss, lane, 1); ss += shx(ss, lane, 2); ss += shx(ss, lane, 4); ss += shx(ss, lane, 8);
                        v4u sg; sg.x = pk2(f0 * ga[0], f1 * ga[1]); sg.y = pk2(f2 * ga[2], f3 * ga[3]); sg.z = pk2(f4 * gb[0], f5 * gb[1]); sg.w = pk2(f6 * gb[2], f7 * gb[3]);
                        { LAS bf16* vq = vimg + q * 136 + 32 * (dch >> 2) + 4 * (dch & 3);
                          v2u s0, s1; s0.x = sg.x; s0.y = sg.y; s1.x = sg.z; s1.y = sg.w; *(LAS v2u*)vq = s0; *(LAS v2u*)(vq + 16) = s1; }
                        if (dch == 0) rsq[q] = __builtin_amdgcn_rsqf(ss * (1.0f / 128.0f) + EPS);
                    }
                    { const int un = unit + G < NB * 32 * 4 ? unit + G : unit; const int gn_ = un & 3, tn = (un >> 7) * SEQ + ((un >> 2) & 31) * 128;
#pragma unroll
                        for (int i = 0; i < 4; ++i) raw[i] = *(const v4u*)(VS + (size_t)(tn + (tid >> 4) + 32 * i) * 512 + gn_ * 128 + 8 * dch); }
                    asm volatile("s_waitcnt lgkmcnt(0)\n\ts_barrier" ::: "memory");
                    f32x4 acc[8];
#pragma unroll
                    for (int nb = 0; nb < 8; ++nb) acc[nb] = (f32x4){0.f, 0.f, 0.f, 0.f};
                    const LAS bf16* ta = vimg + (kq + ((lane & 15) >> 2)) * 136 + 4 * (lane & 3);
#pragma unroll
                    for (int ks = 0; ks < 4; ++ks) if (ks < nks) {
                        const int q0 = 32 * ks + kq;
                        const f32x4 r0 = *(const LAS f32x4*)(rsq + q0), r1 = *(const LAS f32x4*)(rsq + q0 + 4);
                        v4u wb; wb.x = pk2(wreg[ks][0] * r0[0], wreg[ks][1] * r0[1]); wb.y = pk2(wreg[ks][2] * r0[2], wreg[ks][3] * r0[3]); wb.z = pk2(wreg[ks][4] * r1[0], wreg[ks][5] * r1[1]); wb.w = pk2(wreg[ks][6] * r1[2], wreg[ks][7] * r1[3]);
                        const bf16x8 bfrag = __builtin_bit_cast(bf16x8, wb);
#pragma unroll
                        for (int nb = 0; nb < 8; ++nb) {
                            typedef short s16x4_t __attribute__((ext_vector_type(4)));
                            const s16x4_t lo = __builtin_bit_cast(s16x4_t, __builtin_amdgcn_ds_read_tr16_b64_v4i16((LAS s16x4_t*)(ta + (32 * ks) * 136 + 16 * nb)));
                            const s16x4_t hi = __builtin_bit_cast(s16x4_t, __builtin_amdgcn_ds_read_tr16_b64_v4i16((LAS s16x4_t*)(ta + (32 * ks + 4) * 136 + 16 * nb)));
                            const bf16x8 afrag = (bf16x8){lo[0], lo[1], lo[2], lo[3], hi[0], hi[1], hi[2], hi[3]};
                            acc[nb] = __builtin_amdgcn_mfma_f32_16x16x32_bf16(afrag, bfrag, acc[nb], 0, 0, 0);
                        }
                    }
#pragma unroll
                    for (int k = 0; k < 4; ++k) { const int d = 32 * k + 8 * (lane >> 4); const f32x4 a0 = acc[2 * k], a1 = acc[2 * k + 1]; const v4u uu = ur[k];
                        const float y0 = bf2f(uu.x & 0xffffu) * (a0[0] + bias), y1 = bf2f(uu.x >> 16) * (a0[1] + bias), y2 = bf2f(uu.y & 0xffffu) * (a0[2] + bias), y3 = bf2f(uu.y >> 16) * (a0[3] + bias);
                        const float y4 = bf2f(uu.z & 0xffffu) * (a1[0] + bias), y5 = bf2f(uu.z >> 16) * (a1[1] + bias), y6 = bf2f(uu.w & 0xffffu) * (a1[2] + bias), y7 = bf2f(uu.w >> 16) * (a1[3] + bias);
                        v4u o; o.x = pk2(y0, y1); o.y = pk2(y2, y3); o.z = pk2(y4, y5); o.w = pk2(y6, y7);
                        *(v4u*)(MIX + (size_t)(t0 + p) * 1024 + g * 128 + d) = o; }
                    asm volatile("s_waitcnt lgkmcnt(0)\n\ts_barrier" ::: "memory");
                }
            }
        }
        SEAM(pb + 1);
        if (HAVE(5) && IN(pb + 3)) {
            MK_IDS
            unsigned char* ws = KWS(); unsigned char* wl = ws + WS_W + (size_t)l * W_LAYER;
            pg8::Gemm g{(const bf16*)(ws + WS_MIX), (const bf16*)(wl + W_OUT), M, DMODEL, DMODEL, DMODEL}; pg8::StaticOrder S; S.init(M, DMODEL, G, bx);
            pg8::EpiResid E{(bf16*)(ws + WS_HB), (float*)(ws + WS_PART), (LAS float*)((LAS unsigned char*)lds + XCH_OFF)};
            pg8::gemm_phase<pg8::EpiResid, pg8::StaticOrder, true, true, true>((LAS unsigned char*)lds, g, S, E, tid);
        }
        SEAM(pb + 3);
        if (HAVE(6) && IN(pb + 4)) {
            MK_IDS
            unsigned char* ws = KWS(); unsigned char* wl = ws + WS_W + (size_t)l * W_LAYER;
            pg8::Gemm g{(const bf16*)(ws + WS_HB), (const bf16*)(wl + W_UP), M, NUP, DMODEL, DMODEL}; pg8::StaticOrder S; S.init(M, NUP, G, bx);
            pg8::EpiUp E{(const float*)(ws + WS_PART), KIN(15) + (size_t)l * 3 * NUP, KIN(16) + (size_t)l * NUP, (bf16*)(ws + WS_R), (bf16*)(ws + WS_TOP), (bf16*)(ws + WS_BOT), (LAS unsigned char*)lds};
            pg8::gemm_phase<pg8::EpiUp, pg8::StaticOrder, true, true, true>((LAS unsigned char*)lds, g, S, E, tid);
        }
        SEAM(pb + 4);
        if (HAVE(7) && IN(pb + 5)) {
            MK_IDS
            unsigned char* ws = KWS(); const bf16* TOP = (const bf16*)(ws + WS_TOP); const bf16* BOT = (const bf16*)(ws + WS_BOT); bf16* ACT = (bf16*)(ws + WS_R);
            const float* cw = KIN(15) + (size_t)l * 3 * NUP; const float* cb = KIN(16) + (size_t)l * NUP;
            const int T = bx * 512 + tid, cq = T % 704, rg = T / 704; const int NRG = (G * 512) / 704;
            if (rg < NRG) {
                const int c = 4 * cq;
                const f32x4 kb_g = *(const f32x4*)(cb + c), k2_g = *(const f32x4*)(cw + 2 * 5632 + c), k1_g = *(const f32x4*)(cw + 5632 + c), k0_g = *(const f32x4*)(cw + c);
                const f32x4 kb_v = *(const f32x4*)(cb + 2816 + c), k2_v = *(const f32x4*)(cw + 2 * 5632 + 2816 + c), k1_v = *(const f32x4*)(cw + 5632 + 2816 + c), k0_v = *(const f32x4*)(cw + 2816 + c);
                constexpr int NIT = 6;
                f32x4 g2[NIT], g1[NIT], g0[NIT], v2[NIT], v1[NIT], v0[NIT]; float m1[NIT], m0[NIT]; int rowi[NIT];
#pragma unroll
                for (int it = 0; it < NIT; ++it) {
                    const int ri = rg + NRG * it; const bool valid = ri < 1024; const int rc = valid ? ri : rg;
                    const int blk = rc >> 1, rr = rc & 1; const bool first = (blk & 63) == 0; const int bp = first ? blk : blk - 1;
                    const bf16* t0 = TOP + (size_t)(blk * 2) * 5632 + c; const bf16* t1 = t0 + 5632;
                    const bf16* b0 = BOT + (size_t)(bp * 2) * 5632 + c; const bf16* b1 = b0 + 5632;
                    const bf16* p2 = rr ? t1 : t0; const bf16* p1 = rr ? t0 : b1; const bf16* p0 = rr ? b1 : b0;
#define FX_LD(p) ([&]() { const v2u r_ = *(const v2u*)(p); return (f32x4){bf2f(r_.x & 0xffffu), bf2f(r_.x >> 16), bf2f(r_.y & 0xffffu), bf2f(r_.y >> 16)}; }())
                    g2[it] = FX_LD(p2); v2[it] = FX_LD(p2 + 2816); g1[it] = FX_LD(p1); v1[it] = FX_LD(p1 + 2816); g0[it] = FX_LD(p0); v0[it] = FX_LD(p0 + 2816);
#undef FX_LD
                    m1[it] = (first && !rr) ? 0.f : 1.f; m0[it] = first ? 0.f : 1.f; rowi[it] = valid ? 64 * blk + rr : -1;
                }
#pragma unroll
                for (int it = 0; it < NIT; ++it) {
                    const f32x4 cg = kb_g + k2_g * g2[it] + k1_g * (g1[it] * m1[it]) + k0_g * (g0[it] * m0[it]);
                    const f32x4 cv = kb_v + k2_v * v2[it] + k1_v * (v1[it] * m1[it]) + k0_v * (v0[it] * m0[it]);
                    v2u o; o.x = pk2(pg8::silu_f(cg[0]) * cv[0], pg8::silu_f(cg[1]) * cv[1]); o.y = pk2(pg8::silu_f(cg[2]) * cv[2], pg8::silu_f(cg[3]) * cv[3]);
                    if (rowi[it] >= 0) *(v2u*)(ACT + (size_t)rowi[it] * pg8::ACT_LD + c) = o;
                }
            }
        }
        SEAM(pb + 5);
        if (HAVE(8) && IN(pb + 6)) {
            MK_IDS
            unsigned char* ws = KWS(); unsigned char* wl = ws + WS_W + (size_t)l * W_LAYER;
            pg8::Gemm g{(const bf16*)(ws + WS_R), (const bf16*)(wl + W_DN), M, DMODEL, D_FF, pg8::ACT_LD}; pg8::StaticOrder S; S.init(M, DMODEL, G, bx);
            pg8::EpiResid E{(bf16*)(ws + WS_HB), (float*)(ws + WS_PART), (LAS float*)((LAS unsigned char*)lds + XCH_OFF)};
            pg8::gemm_phase<pg8::EpiResid, pg8::StaticOrder, true, true, true>((LAS unsigned char*)lds, g, S, E, tid);
        }
        SEAM(pb + 6);
    }
    if (HAVE(9) && IN(15)) {
        MK_IDS
        float* out = KOUT(); const float* final_norm = KIN(18); unsigned char* ws = KWS(); const float* PART = (const float*)(ws + WS_PART); const bf16* HB = (const bf16*)(ws + WS_HB);
        const f32x4* gr = (const f32x4*)final_norm + lane; const f32x4 g0 = gr[0], g1 = gr[64], g2 = gr[128], g3 = gr[192];
        for (int m0 = gw; m0 < M; m0 += 4 * NGW) {
            v2u r[4][4]; f32x4 pp[4];
#pragma unroll
            for (int k = 0; k < 4; ++k) { const int m = (m0 + k * NGW < M) ? m0 + k * NGW : m0; const v2u* hr = (const v2u*)(HB + (size_t)m * DMODEL) + lane;
#pragma unroll
                for (int j = 0; j < 4; ++j) r[k][j] = hr[64 * j];
                pp[k] = *(const f32x4*)(PART + (size_t)m * 4); }
#pragma unroll
            for (int k = 0; k < 4; ++k) { const int m = m0 + k * NGW; if (m < M) {
                const float rs = pg8::rs_of(pp[k]); f32x4* xr = (f32x4*)(out + (size_t)m * DMODEL) + lane;
#pragma unroll
                for (int j = 0; j < 4; ++j) { const v2u q = r[k][j]; const f32x4 w = {bf2f(q.x & 0xffffu), bf2f(q.x >> 16), bf2f(q.y & 0xffffu), bf2f(q.y >> 16)}; const f32x4 g = j == 0 ? g0 : j == 1 ? g1 : j == 2 ? g2 : g3; xr[64 * j] = w * rs * g; }
            } }
        }
    }
#if MK_TS >= 0
    {
        __syncthreads();
        if (wave_s == 0 && blockIdx.x == 0 && __builtin_amdgcn_mbcnt_hi(~0u, __builtin_amdgcn_mbcnt_lo(~0u, 0u)) == 0) {
            unsigned long long* ts = (unsigned long long*)(KWS() + 65536); ts[16] = __builtin_amdgcn_s_memrealtime();
            unsigned long long span;
            if (MK_TS == 0) span = ts[1] - ts[0];
            else if (MK_TS <= 7) span = (ts[1 + MK_TS] - ts[MK_TS]) + (ts[8 + MK_TS] - ts[7 + MK_TS]);
            else if (MK_TS == 8) span = ts[16] - ts[15];
            else if (MK_TS == 21) span = 100ull * 1000ull * (ts[32 + 6] - ts[32 + 5]) / (ts[6] - ts[5]) / 100ull;
            else if (MK_TS == 20 || MK_TS == 22 || MK_TS == 23) { const unsigned long long* pw = (const unsigned long long*)(KWS() + WS_PARK + (size_t)16384 * 256 * 4); span = (pw[0] + pw[1] + pw[2] + pw[3]) / 10; }
            else span = ts[16] - ts[0];
            KOUT()[0] = ((float)span * 0.01f - (float)(MK_TSOFF)) * (MK_TS == 9 ? 0.01f : 0.1f);
        }
    }
#endif
#undef IN
#undef SEAM
}

#ifndef MK_LAST
#define MK_LAST NPH
#endif
#ifndef MK_SPLIT
#define MK_SPLIT 0
#endif
extern "C" void kernel_launch(void* const* d_in, const int* in_sizes, int n_in, void* d_out, int out_size, void* d_ws, size_t ws_size, hipStream_t stream) {
    static int grid = 0;
    if (grid == 0) {
        if (n_in != 19 || in_sizes[0] != M * DMODEL || out_size != M * DMODEL || ws_size < WS_TOTAL) {
            fprintf(stderr, "kernel_launch: unexpected shapes: n_in %d in0 %d out %d ws %zu (need %zu); nothing launched\n", n_in, n_in > 0 ? in_sizes[0] : -1, out_size, ws_size, (size_t)WS_END); grid = -1; return; }
        int dev = 0, cus = 0, per_cu = 0;
        if (hipGetDevice(&dev) != hipSuccess || hipDeviceGetAttribute(&cus, hipDeviceAttributeMultiprocessorCount, dev) != hipSuccess) { grid = -1; return; }
        if (hipFuncSetAttribute((const void*)mk_fwd, hipFuncAttributeMaxDynamicSharedMemorySize, LDS_BYTES) != hipSuccess) { fprintf(stderr, "kernel_launch: hipFuncSetAttribute failed\n"); grid = -1; return; }
        if (hipOccupancyMaxActiveBlocksPerMultiprocessor(&per_cu, (const void*)mk_fwd, 512, LDS_BYTES) != hipSuccess || per_cu < 1) { fprintf(stderr, "kernel_launch: occupancy query gives %d\n", per_cu); per_cu = 1; }
        (void)hipGetLastError();
        grid = cus;
        fprintf(stderr, "kernel_launch: cus %d per_cu %d grid %d ws %zu\n", cus, per_cu, grid, ws_size);
    }
    if (grid < 0) return;
    if (hipMemsetAsync((char*)d_ws + WS_CTL, 0, 65536, stream) != hipSuccess) { fprintf(stderr, "kernel_launch: hipMemsetAsync of the barrier words failed; nothing launched\n"); return; }
    Args a{};
    for (int i = 0; i < 19; ++i) a.in[i] = d_in[i];
    a.out = (float*)d_out; a.ws = (unsigned char*)d_ws;
#if MK_SPLIT
    for (int p = 0; p < NPH; ++p) { a.ph_lo = p; a.ph_hi = p + 1; void* args[] = {&a};
        hipError_t e = hipLaunchCooperativeKernel((const void*)mk_fwd, dim3(grid), dim3(512), args, LDS_BYTES, stream);
        if (e != hipSuccess) { fprintf(stderr, "launch %d failed: %s\n", p, hipGetErrorString(e)); break; } }
#else
    a.ph_lo = 0; a.ph_hi = MK_LAST; void* args[] = {&a};
    hipError_t e = hipLaunchCooperativeKernel((const void*)mk_fwd, dim3(grid), dim3(512), args, LDS_BYTES, stream);
    if (e != hipSuccess) fprintf(stderr, "cooperative launch failed: %s (grid %d)\n", hipGetErrorString(e), grid);
#endif
}
```
